# Optimizing an MI355X kernel written in HIP

```python
import jax, jax.numpy as jnp
from jax import lax
import numpy as np

D_MODEL = 2048
BATCH = 1
SEQ = 8192
DEPTH = 1

N_MEM = 256
WIDTH_A = D_MODEL
WIDTH_B = D_MODEL
MIX_WIDTH = WIDTH_A + WIDTH_B
HEAD_DIM = 128
N_HEADS_B = WIDTH_B // HEAD_DIM
CONV_WIDTH_A = 3
CONV_WIDTH_B = 4
LRU_C = 8.0
XATTN_HEADS = 4
XATTN_HEAD_DIM = D_MODEL // XATTN_HEADS
IN_COLS = 4 * WIDTH_A + 2 * WIDTH_B
RMS_EPS = 1e-6

kernel_name = "hymba_shortconv_rglru_memxattn"


def rms_norm(x, g):
    xf = x.astype(jnp.float32)
    y = xf * lax.rsqrt(jnp.mean(xf * xf, axis=-1, keepdims=True) + RMS_EPS)
    return (y * g.astype(jnp.float32)).astype(x.dtype)


def causal_depthwise_conv(u, w, b):
    k_width = w.shape[0]
    s = u.shape[1]
    up = jnp.pad(u, ((0, 0), (k_width - 1, 0), (0, 0)))
    y = b
    for k in range(k_width):
        y = y + up[:, k:k + s] * w[k]
    return y


def _lin_rec_combine(c1, c2):
    a1, b1 = c1
    a2, b2 = c2
    return a1 * a2, a2 * b1 + b2


def rg_lru(xc, w_r, b_r, w_i, b_i, lam):
    bsz, s, _ = xc.shape
    xh = xc.reshape(bsz, s, N_HEADS_B, HEAD_DIM)
    r_pre = jnp.einsum('bshi,hij->bshj', xh, w_r).reshape(bsz, s, WIDTH_B) + b_r
    i_pre = jnp.einsum('bshi,hij->bshj', xh, w_i).reshape(bsz, s, WIDTH_B) + b_i
    r = jax.nn.sigmoid(r_pre.astype(jnp.float32))
    i = jax.nn.sigmoid(i_pre.astype(jnp.float32))
    log_a = -LRU_C * r * jax.nn.softplus(-lam.astype(jnp.float32))
    a = jnp.exp(log_a)
    mult = jnp.sqrt(-jnp.expm1(2.0 * log_a))
    mult = mult.at[:, 0].set(1.0)
    u = mult * i * xc.astype(jnp.float32)
    _, h = lax.associative_scan(_lin_rec_combine, (a, u), axis=1)
    return h.astype(xc.dtype)


def memory_cross_attention(hn, mn, w_q, w_kv, w_o):
    bsz, s, _ = hn.shape
    m = mn.shape[1]
    q = (hn @ w_q).reshape(bsz, s, XATTN_HEADS, XATTN_HEAD_DIM)
    kv = mn @ w_kv
    k = kv[..., :D_MODEL].reshape(bsz, m, XATTN_HEADS, XATTN_HEAD_DIM)
    v = kv[..., D_MODEL:].reshape(bsz, m, XATTN_HEADS, XATTN_HEAD_DIM)
    scores = jnp.einsum('bshd,bmhd->bhsm', q, k).astype(jnp.float32) * (XATTN_HEAD_DIM ** -0.5)
    p = jax.nn.softmax(scores, axis=-1).astype(v.dtype)
    o = jnp.einsum('bhsm,bmhd->bshd', p, v).reshape(bsz, s, D_MODEL)
    return o @ w_o


def setup_inputs(seed: int = 0) -> dict:
    key = jax.random.key(seed)
    ks = jax.random.split(key, 24)
    f32 = jnp.float32
    nrm = lambda k, shape, scale: jax.random.normal(k, shape, f32) * scale
    a_base = jax.random.uniform(ks[10], (DEPTH, WIDTH_B), f32, 0.9, 0.999)
    return {
        "x": nrm(ks[0], (BATCH, SEQ, D_MODEL), 1.0),
        "mem": nrm(ks[1], (BATCH, N_MEM, D_MODEL), 1.0),
        "norm_mix_g": 1.0 + nrm(ks[2], (DEPTH, D_MODEL), 0.02),
        "w_in": nrm(ks[3], (DEPTH, D_MODEL, IN_COLS), D_MODEL ** -0.5),
        "conv_a_w": nrm(ks[4], (DEPTH, CONV_WIDTH_A, WIDTH_A), CONV_WIDTH_A ** -0.5),
        "conv_a_b": nrm(ks[5], (DEPTH, WIDTH_A), 0.01),
        "conv_b_w": nrm(ks[6], (DEPTH, CONV_WIDTH_B, WIDTH_B), CONV_WIDTH_B ** -0.5),
        "conv_b_b": nrm(ks[7], (DEPTH, WIDTH_B), 0.01),
        "w_rgate": nrm(ks[8], (DEPTH, N_HEADS_B, HEAD_DIM, HEAD_DIM), HEAD_DIM ** -0.5),
        "b_rgate": nrm(ks[9], (DEPTH, WIDTH_B), 0.01),
        "w_igate": nrm(ks[11], (DEPTH, N_HEADS_B, HEAD_DIM, HEAD_DIM), HEAD_DIM ** -0.5),
        "b_igate": nrm(ks[12], (DEPTH, WIDTH_B), 0.01),
        "lru_lambda": jnp.log(a_base) - jnp.log1p(-a_base),
        "w_out": nrm(ks[13], (DEPTH, MIX_WIDTH, D_MODEL), MIX_WIDTH ** -0.5),
        "norm_x_g": 1.0 + nrm(ks[14], (DEPTH, D_MODEL), 0.02),
        "norm_mem_g": 1.0 + nrm(ks[15], (DEPTH, D_MODEL), 0.02),
        "w_q": nrm(ks[16], (DEPTH, D_MODEL, D_MODEL), D_MODEL ** -0.5),
        "w_kv": nrm(ks[17], (DEPTH, D_MODEL, 2 * D_MODEL), D_MODEL ** -0.5),
        "w_o": nrm(ks[18], (DEPTH, D_MODEL, D_MODEL), D_MODEL ** -0.5),
        "norm_f_g": 1.0 + nrm(ks[19], (D_MODEL,), 0.02),
    }


def reference(x, mem, norm_mix_g, w_in, conv_a_w, conv_a_b, conv_b_w, conv_b_b,
              w_rgate, b_rgate, w_igate, b_igate, lru_lambda, w_out,
              norm_x_g, norm_mem_g, w_q, w_kv, w_o, norm_f_g):
    h = x
    for l in range(DEPTH):
        hn = rms_norm(h, norm_mix_g[l])
        proj = hn @ w_in[l]
        v_a, b_a, c_a, g_a, x_b, g_b = jnp.split(
            proj, np.cumsum([WIDTH_A] * 4 + [WIDTH_B])[:].tolist(), axis=-1)
        y_a = b_a * causal_depthwise_conv(c_a * v_a, conv_a_w[l], conv_a_b[l])
        y_a = y_a * jax.nn.silu(g_a)
        x_c = causal_depthwise_conv(x_b, conv_b_w[l], conv_b_b[l])
        y_b = rg_lru(x_c, w_rgate[l], b_rgate[l], w_igate[l], b_igate[l], lru_lambda[l])
        y_b = y_b * jax.nn.silu(g_b)
        h = h + jnp.concatenate([y_a, y_b], axis=-1) @ w_out[l]
        h = h + memory_cross_attention(rms_norm(h, norm_x_g[l]), rms_norm(mem, norm_mem_g[l]),
                                       w_q[l], w_kv[l], w_o[l])
    return rms_norm(h, norm_f_g)
```

```cpp
#include <hip/hip_runtime.h>
#include <hip/hip_cooperative_groups.h>
#include <cstdio>
#include <cstdint>
namespace cg = cooperative_groups;

#ifndef MK_N_LAUNCHES
#define MK_N_LAUNCHES 1
#endif

namespace pg8 {
#define PG8_LAS __attribute__((address_space(3)))
typedef unsigned short bf16_t;
typedef short bf16x8 __attribute__((ext_vector_type(8)));
typedef float f32x4 __attribute__((ext_vector_type(4)));
typedef unsigned u32x4 __attribute__((ext_vector_type(4)));
constexpr int BM = 256, BK = 64, HALF = 128, HTB = HALF * BK * 2, STAGE_BYTES = 8 * HTB, NXCD = 8, WGM = 8;

__host__ __device__ __forceinline__ int lds_byte(int r, int c) { const int st = (r >> 4) * 2 + (c >> 5), rr = r & 15, cc = c & 31, ob = rr * 64 + cc * 2; return st * 1024 + (ob ^ (((ob >> 9) & 1) << 5)); }
__host__ __device__ __forceinline__ void stage_rc(int b, int& R, int& C) { const int st = b / 1024, sb = b % 1024, swz = sb ^ (((sb >> 9) & 1) << 5); R = (st >> 1) * 16 + swz / 64; C = (st & 1) * 32 + (swz % 64) / 2; }
__host__ __device__ __forceinline__ int perm32(int rho) { const int n = rho >> 4, i = rho & 15; return 8 * (i >> 2) + 4 * n + (i & 3); }

struct Unit { int pm, pn; };
struct Gemm { int lda, ldb, K; };

__device__ __forceinline__ unsigned cvt_pk_bf16(float lo, float hi) { unsigned r; asm volatile("v_cvt_pk_bf16_f32 %0, %1, %2" : "=v"(r) : "v"(lo), "v"(hi)); return r; }

struct SchedStd {
    const char* A; const char* B; size_t strideA, strideB;
    int nM, nN, nwg, G, c;
    __device__ __forceinline__ void init(const void* A_, int lda, const void* B_, int ldb, int M, int N, int G_, int c_) {
        A = (const char*)A_; B = (const char*)B_; strideA = (size_t)BM * lda * 2; strideB = (size_t)BM * ldb * 2; nM = M / BM; nN = N / BM; nwg = nM * nN; G = G_; c = c_; }
    __device__ __forceinline__ bool next(int i, Unit& u) const {
        const long L = (long)i * G + c; if (L >= nwg) return false;
        int wgid = (int)L; { const int q = nwg / NXCD, r = nwg % NXCD, xcd = wgid % NXCD, off = wgid / NXCD; wgid = (xcd < r ? xcd * (q + 1) : r * (q + 1) + (xcd - r) * q) + off; }
        const int nig = WGM * nN, gid = wgid / nig, fm = gid * WGM, gsz = (nM - fm) < WGM ? (nM - fm) : WGM;
        u.pm = fm + ((wgid % nig) % gsz); u.pn = (wgid % nig) / gsz; return true;
    }
    __device__ __forceinline__ const char* a_base(const Unit& u) const { return A + (size_t)u.pm * strideA; }
    __device__ __forceinline__ const char* b_base(const Unit& u) const { return B + (size_t)u.pn * strideB; }
};

template <class Epi, class Sched, bool ALIGN_EPI>
__device__ __forceinline__ void gemm_phase(PG8_LAS unsigned char* lds, const Gemm g, const Sched& S, const Epi& E) {
    const int tid = threadIdx.x, wid = __builtin_amdgcn_readfirstlane(tid >> 6), lane = tid & 63, wr = wid >> 2, wc = wid & 3, fr = lane & 15, fq = lane >> 4;
    const int K = g.K, nt = K / BK;
    unsigned voffA[2], voffB[2];
#pragma unroll
    for (int i = 0; i < 2; ++i) { int R, C; stage_rc(tid * 16 + i * 8192, R, C); const int Rb = Epi::PERM ? ((R & ~31) + perm32(R & 31)) : R;
        voffA[i] = (unsigned)(R * g.lda + C) * 2u; voffB[i] = (unsigned)(Rb * g.ldb + C) * 2u; }
    const size_t kstep = (size_t)(BK * 2);
    const size_t hA = (size_t)HALF * g.lda * 2, hB = (size_t)HALF * g.ldb * 2;
    const unsigned ldsw = (unsigned)wid * 1024u;
    const int aoff = lds_byte(wr * 64 + fr, fq * 8), boff = lds_byte(wc * 32 + fr, fq * 8);
#define PG8_SA(b, h) (((b) * 2 + (h)) * HTB)
#define PG8_SB(b, h) ((4 + (b) * 2 + (h)) * HTB)
#define PG8_STAGE(bufoff, gbase, voff) do { _Pragma("unroll") for (int _i = 0; _i < 2; ++_i) \
        __builtin_amdgcn_global_load_lds((const unsigned*)((const char*)(gbase) + (voff)[_i]), (PG8_LAS unsigned*)(lds + (bufoff) + ldsw + _i * 8192), 16, 0, 0); } while (0)
#define PG8_LDA(dst, b, h) do { _Pragma("unroll") for (int m = 0; m < 4; ++m) _Pragma("unroll") for (int k = 0; k < 2; ++k) dst[m][k] = *(const PG8_LAS bf16x8*)(lds + PG8_SA(b, h) + aoff + m * 2048 + k * 1024); } while (0)
#define PG8_LDB(dst, b, h) do { _Pragma("unroll") for (int n = 0; n < 2; ++n) _Pragma("unroll") for (int k = 0; k < 2; ++k) dst[n][k] = *(const PG8_LAS bf16x8*)(lds + PG8_SB(b, h) + boff + n * 2048 + k * 1024); } while (0)
#define PG8_MMA(ai, bj, At, Bt) do { __builtin_amdgcn_s_setprio(1); _Pragma("unroll") for (int m = 0; m < 4; ++m) _Pragma("unroll") for (int n = 0; n < 2; ++n) _Pragma("unroll") for (int k = 0; k < 2; ++k) \
        acc[ai][bj][m][n] = __builtin_amdgcn_mfma_f32_16x16x32_bf16(Bt[n][k], At[m][k], acc[ai][bj][m][n], 0, 0, 0); __builtin_amdgcn_s_setprio(0); } while (0)
#define PG8_WAIT_V(n) asm volatile("s_waitcnt vmcnt(" #n ")" ::: "memory")
#define PG8_WAIT_L(n) asm volatile("s_waitcnt lgkmcnt(" #n ")" ::: "memory")
#define PG8_BAR __builtin_amdgcn_s_barrier()
#define PG8_SCHED __builtin_amdgcn_sched_barrier(0)
    Unit cur, nxt; int ui = 0;
    if (!S.next(0, cur)) return;
    f32x4 acc[2][2][4][2];
#pragma unroll
    for (int a = 0; a < 2; ++a)
#pragma unroll
        for (int b = 0; b < 2; ++b)
#pragma unroll
            for (int m = 0; m < 4; ++m)
#pragma unroll
                for (int n = 0; n < 2; ++n) acc[a][b][m][n] = (f32x4){0.f, 0.f, 0.f, 0.f};
    bf16x8 At[4][2], B0[2][2], B1[2][2];
    const char* cA = S.a_base(cur); const char* cB = S.b_base(cur);
    PG8_STAGE(PG8_SB(0, 0), cB, voffB); PG8_STAGE(PG8_SB(0, 1), cB + hB, voffB); PG8_STAGE(PG8_SA(0, 0), cA, voffA); PG8_STAGE(PG8_SA(0, 1), cA + hA, voffA);
    if (wr == 1) PG8_BAR;
    PG8_WAIT_V(2); PG8_BAR;
    PG8_STAGE(PG8_SB(1, 0), cB + kstep, voffB); PG8_STAGE(PG8_SA(1, 0), cA + kstep, voffA); PG8_STAGE(PG8_SB(1, 1), cB + hB + kstep, voffB);
    PG8_WAIT_V(6); PG8_BAR;
    for (;;) {
        const bool has_next = S.next(ui + 1, nxt);
        const char* nA = has_next ? S.a_base(nxt) : cA; const char* nB = has_next ? S.b_base(nxt) : cB;
        for (int t = 0; t < nt; t += 2) {
            const bool last = (t == nt - 2);
            const char* a1 = cA + (size_t)(t + 1) * kstep;
            const char* a2 = last ? nA : cA + (size_t)(t + 2) * kstep; const char* b2 = last ? nB : cB + (size_t)(t + 2) * kstep;
            const char* a3 = a2 + kstep; const char* b3 = b2 + kstep;
            PG8_LDB(B0, 0, 0); PG8_LDB(B1, 0, 1); PG8_SCHED; PG8_LDA(At, 0, 0); PG8_STAGE(PG8_SA(1, 1), a1 + hA, voffA);
            PG8_WAIT_V(8); PG8_WAIT_L(0); PG8_BAR; PG8_MMA(0, 0, At, B0); PG8_MMA(0, 1, At, B1); PG8_BAR; PG8_SCHED;
            PG8_LDA(At, 0, 1); PG8_STAGE(PG8_SB(0, 0), b2, voffB); PG8_STAGE(PG8_SB(0, 1), b2 + hB, voffB); PG8_STAGE(PG8_SA(0, 0), a2, voffA);
            PG8_WAIT_V(8); PG8_WAIT_L(0); PG8_BAR; PG8_MMA(1, 0, At, B0); PG8_MMA(1, 1, At, B1); PG8_BAR; PG8_SCHED;
            PG8_LDB(B0, 1, 0); PG8_LDB(B1, 1, 1); PG8_SCHED; PG8_LDA(At, 1, 0); PG8_STAGE(PG8_SA(0, 1), a2 + hA, voffA);
            PG8_WAIT_V(8); PG8_WAIT_L(0); PG8_BAR; PG8_MMA(0, 0, At, B0); PG8_MMA(0, 1, At, B1); PG8_BAR; PG8_SCHED;
            PG8_LDA(At, 1, 1); PG8_STAGE(PG8_SB(1, 0), b3, voffB); PG8_STAGE(PG8_SB(1, 1), b3 + hB, voffB); PG8_STAGE(PG8_SA(1, 0), a3, voffA);
            PG8_WAIT_V(8); PG8_WAIT_L(0); PG8_BAR; PG8_MMA(1, 0, At, B0); PG8_MMA(1, 1, At, B1); PG8_BAR; PG8_SCHED;
        }
        if constexpr (ALIGN_EPI) { if (wr == 0) PG8_BAR; }
        if constexpr (!Epi::AFTER_DRAIN) { E(acc, cur, wr, wc, fr, fq); }
        if (!has_next) break;
#pragma unroll
        for (int a = 0; a < 2; ++a)
#pragma unroll
            for (int b = 0; b < 2; ++b)
#pragma unroll
                for (int m = 0; m < 4; ++m)
#pragma unroll
                    for (int n = 0; n < 2; ++n) acc[a][b][m][n] = (f32x4){0.f, 0.f, 0.f, 0.f};
        cur = nxt; cA = nA; cB = nB; ++ui;
        if constexpr (ALIGN_EPI) { if (wr == 1) PG8_BAR; }
    }
    PG8_WAIT_V(0);
    if constexpr (!ALIGN_EPI) { if (wr == 0) PG8_BAR; }
    PG8_BAR;
    if constexpr (Epi::AFTER_DRAIN) { E.fused(acc, cur, wr, wc, fr, fq, lds, wid, lane); }
#undef PG8_SA
#undef PG8_SB
#undef PG8_STAGE
#undef PG8_LDA
#undef PG8_LDB
#undef PG8_MMA
#undef PG8_WAIT_V
#undef PG8_WAIT_L
#undef PG8_BAR
#undef PG8_SCHED
}
}

constexpr int NWAVES = 8;
constexpr int SEQ = 8192, DM = 2048, NMEM = 256, INC = 12288, MIXW = 4096, NHB = 16, HD = 128, XH = 4, XHD = 512;
constexpr float RMS_EPS = 1e-6f;
constexpr int N_PHASES = 10;

constexpr size_t MiB = 1u << 20;
constexpr size_t WS_ROWSS = 0;
constexpr size_t WS_WG = 1 * MiB;
constexpr size_t WS_MN = 2 * MiB;
constexpr size_t WS_KB = 3 * MiB;
constexpr size_t WS_VT = 4 * MiB;
constexpr size_t WS_AGG = 5 * MiB;
constexpr size_t WS_LP = 7 * MiB;
constexpr size_t WS_WOUT = 8 * MiB;
constexpr size_t WS_WQ = 24 * MiB;
constexpr size_t WS_WO = 32 * MiB;
constexpr size_t WS_WIN = 40 * MiB;
constexpr size_t WS_WKV = 88 * MiB;
constexpr size_t WS_XN = 104 * MiB;
constexpr size_t WS_YCAT = 40 * MiB;
constexpr size_t WS_PROJ = 136 * MiB;
constexpr size_t WS_H1B = 136 * MiB;
constexpr size_t WS_Q = 168 * MiB;
constexpr size_t WS_P = 200 * MiB;
constexpr size_t WS_O = 216 * MiB;
constexpr size_t WS_END = 328 * MiB;

constexpr int RING_BYTES = 131072;
constexpr int LDS_BYTES = 147456;

#define GAS __attribute__((address_space(1)))
#define LAS __attribute__((address_space(3)))
typedef unsigned short bf16;
typedef unsigned v4u __attribute__((ext_vector_type(4)));
typedef unsigned v2u __attribute__((ext_vector_type(2)));
typedef float f32x4 __attribute__((ext_vector_type(4)));
typedef float f32x2 __attribute__((ext_vector_type(2)));
typedef short bf16x8 __attribute__((ext_vector_type(8)));
#define LDS_WAIT() asm volatile("s_waitcnt lgkmcnt(0)" ::: "memory")

__device__ __forceinline__ unsigned pk2(float lo, float hi) { return pg8::cvt_pk_bf16(lo, hi); }
__device__ __forceinline__ float bflo(unsigned v) { return __builtin_bit_cast(float, v << 16); }
__device__ __forceinline__ float bfhi(unsigned v) { return __builtin_bit_cast(float, v & 0xffff0000u); }
__device__ __forceinline__ float wave_sum(float v) {
#pragma unroll
    for (int o = 1; o < 64; o <<= 1) v += __shfl_xor(v, o);
    return v;
}
__device__ __forceinline__ float sigmoidf_(float x) { return 1.0f / (1.0f + __expf(-x)); }

struct Args {
    const float* in[20]; float* out; unsigned char* ws; int ph_lo, ph_hi;
};

struct Frame {
    LAS unsigned char* lds;
    int tid, lane, wave, vcu, G;
    const float *x, *mem, *g_mix, *w_in, *caw, *cab, *cbw, *cbb, *w_r, *b_r, *w_i, *b_i, *lam, *w_out, *g_x, *g_mem, *w_q, *w_kv, *w_o, *g_f;
    float* out; unsigned char* ws;
};

namespace pg8 {
__device__ __forceinline__ void store_tile_bf16(const f32x4 (&acc)[2][2][4][2], bf16_t* tile, int ldc, int wr, int wc, int fr, int fq) {
#pragma unroll
    for (int ai = 0; ai < 2; ++ai)
#pragma unroll
        for (int m = 0; m < 4; ++m) { bf16_t* rowp = tile + (size_t)(ai * HALF + wr * 64 + m * 16 + fr) * ldc + wc * 32 + 8 * fq;
#pragma unroll
            for (int bj = 0; bj < 2; ++bj) { const f32x4 v0 = acc[ai][bj][m][0], v1 = acc[ai][bj][m][1];
                u32x4 w; w.x = cvt_pk_bf16(v0[0], v0[1]); w.y = cvt_pk_bf16(v0[2], v0[3]); w.z = cvt_pk_bf16(v1[0], v1[1]); w.w = cvt_pk_bf16(v1[2], v1[3]);
                *(u32x4*)(rowp + bj * HALF) = w; } }
}
struct EpiProj {
    static constexpr bool PERM = true, AFTER_DRAIN = false;
    bf16_t* O; int ldc;
    __device__ __forceinline__ void operator()(const f32x4 (&acc)[2][2][4][2], const Unit& u, int wr, int wc, int fr, int fq) const {
        store_tile_bf16(acc, O + (size_t)u.pm * BM * ldc + (size_t)u.pn * BM, ldc, wr, wc, fr, fq); }
};
struct SchedKV {
    const char* mn; const char* wkv; int G, c;
    __device__ __forceinline__ bool next(int i, Unit& u) const { const int L = i * G + c; if (L >= 16) return false; u.pm = L; u.pn = 0; return true; }
    __device__ __forceinline__ const char* a_base(const Unit& u) const { return u.pm < 8 ? mn : wkv + (size_t)(2048 + (u.pm - 8) * 256) * 2048 * 2; }
    __device__ __forceinline__ const char* b_base(const Unit& u) const { return u.pm < 8 ? wkv + (size_t)(u.pm * 256) * 2048 * 2 : mn; }
};
struct EpiKV {
    static constexpr bool PERM = true, AFTER_DRAIN = false;
    bf16_t* Kb; bf16_t* Vt;
    __device__ __forceinline__ void operator()(const f32x4 (&acc)[2][2][4][2], const Unit& u, int wr, int wc, int fr, int fq) const {
        if (u.pm < 8) store_tile_bf16(acc, Kb + (size_t)u.pm * BM, 2048, wr, wc, fr, fq);
        else store_tile_bf16(acc, Vt + (size_t)(u.pm - 8) * BM * 256, 256, wr, wc, fr, fq); }
};
struct EpiRes1 {
    static constexpr bool PERM = true, AFTER_DRAIN = false;
    const float* x; float* h1; bf16_t* h1b; float* rowss;
    __device__ __forceinline__ void operator()(const f32x4 (&acc)[2][2][4][2], const Unit& u, int wr, int wc, int fr, int fq) const {
#pragma unroll
        for (int ai = 0; ai < 2; ++ai)
#pragma unroll
            for (int m = 0; m < 4; ++m) { const int row = u.pm * BM + ai * HALF + wr * 64 + m * 16 + fr; float ss = 0.f;
#pragma unroll
                for (int bj = 0; bj < 2; ++bj) { const size_t off = (size_t)row * DM + u.pn * BM + bj * HALF + wc * 32 + 8 * fq;
                    const f32x4 v0 = *(const f32x4*)(x + off) + acc[ai][bj][m][0], v1 = *(const f32x4*)(x + off + 4) + acc[ai][bj][m][1];
                    *(f32x4*)(h1 + off) = v0; *(f32x4*)(h1 + off + 4) = v1;
                    ss += (v0[0] * v0[0] + v0[1] * v0[1]) + (v0[2] * v0[2] + v0[3] * v0[3]) + (v1[0] * v1[0] + v1[1] * v1[1]) + (v1[2] * v1[2] + v1[3] * v1[3]);
                    u32x4 w; w.x = cvt_pk_bf16(v0[0], v0[1]); w.y = cvt_pk_bf16(v0[2], v0[3]); w.z = cvt_pk_bf16(v1[0], v1[1]); w.w = cvt_pk_bf16(v1[2], v1[3]);
                    *(u32x4*)(h1b + off) = w; }
                ss += __shfl_xor(ss, 16); ss += __shfl_xor(ss, 32);
                if (fq == 0) atomicAdd(rowss + row, ss); }
    }
};
struct EpiQ {
    static constexpr bool PERM = true, AFTER_DRAIN = false;
    bf16_t* Q; const float* rowss; float c;
    __device__ __forceinline__ void operator()(const f32x4 (&acc)[2][2][4][2], const Unit& u, int wr, int wc, int fr, int fq) const {
#pragma unroll
        for (int ai = 0; ai < 2; ++ai)
#pragma unroll
            for (int m = 0; m < 4; ++m) { const int row = u.pm * BM + ai * HALF + wr * 64 + m * 16 + fr;
                const float rs = c / sqrtf(rowss[row] * (1.0f / DM) + RMS_EPS);
#pragma unroll
                for (int bj = 0; bj < 2; ++bj) { const size_t off = (size_t)row * DM + u.pn * BM + bj * HALF + wc * 32 + 8 * fq;
                    const f32x4 v0 = acc[ai][bj][m][0] * rs, v1 = acc[ai][bj][m][1] * rs;
                    u32x4 w; w.x = cvt_pk_bf16(v0[0], v0[1]); w.y = cvt_pk_bf16(v0[2], v0[3]); w.z = cvt_pk_bf16(v1[0], v1[1]); w.w = cvt_pk_bf16(v1[2], v1[3]);
                    *(u32x4*)(Q + off) = w; } }
    }
};
struct SchedS {
    const char* q; const char* kb; int G, c;
    __device__ __forceinline__ bool next(int i, Unit& u) const { const int L = i * G + c; if (L >= 128) return false; u.pm = L >> 2; u.pn = L & 3; return true; }
    __device__ __forceinline__ const char* a_base(const Unit& u) const { return q + ((size_t)u.pm * BM * DM + (size_t)u.pn * XHD) * 2; }
    __device__ __forceinline__ const char* b_base(const Unit& u) const { return kb + (size_t)u.pn * XHD * 2; }
};
struct EpiSoftmax {
    static constexpr bool PERM = true, AFTER_DRAIN = true;
    bf16_t* P; float* lpart;
    __device__ __forceinline__ void fused(const f32x4 (&acc)[2][2][4][2], const Unit& u, int wr, int wc, int fr, int fq, PG8_LAS unsigned char* lds, int wid, int lane) const {
        PG8_LAS float* Pm = (PG8_LAS float*)lds;
#pragma unroll
        for (int ai = 0; ai < 2; ++ai)
#pragma unroll
            for (int m = 0; m < 4; ++m) { float mx = -3.0e38f;
#pragma unroll
                for (int bj = 0; bj < 2; ++bj)
#pragma unroll
                    for (int n = 0; n < 2; ++n) { const f32x4 v = acc[ai][bj][m][n]; mx = fmaxf(mx, fmaxf(fmaxf(v[0], v[1]), fmaxf(v[2], v[3]))); }
                mx = fmaxf(mx, __shfl_xor(mx, 16)); mx = fmaxf(mx, __shfl_xor(mx, 32));
                if (fq == 0) Pm[(ai * HALF + wr * 64 + m * 16 + fr) * 4 + wc] = mx; }
        asm volatile("s_waitcnt lgkmcnt(0)" ::: "memory"); __builtin_amdgcn_s_barrier(); asm volatile("" ::: "memory");
#pragma unroll
        for (int ai = 0; ai < 2; ++ai)
#pragma unroll
            for (int m = 0; m < 4; ++m) { const int r = ai * HALF + wr * 64 + m * 16 + fr; const int row = u.pm * BM + r;
                const f32x4 pm4 = *(const PG8_LAS f32x4*)(Pm + r * 4); const float mx = fmaxf(fmaxf(pm4[0], pm4[1]), fmaxf(pm4[2], pm4[3]));
                float l = 0.f;
#pragma unroll
                for (int bj = 0; bj < 2; ++bj) { f32x4 v0 = acc[ai][bj][m][0], v1 = acc[ai][bj][m][1];
#pragma unroll
                    for (int e = 0; e < 4; ++e) { v0[e] = __builtin_amdgcn_exp2f(v0[e] - mx); v1[e] = __builtin_amdgcn_exp2f(v1[e] - mx); }
                    l += (v0[0] + v0[1]) + (v0[2] + v0[3]) + (v1[0] + v1[1]) + (v1[2] + v1[3]);
                    u32x4 w; w.x = cvt_pk_bf16(v0[0], v0[1]); w.y = cvt_pk_bf16(v0[2], v0[3]); w.z = cvt_pk_bf16(v1[0], v1[1]); w.w = cvt_pk_bf16(v1[2], v1[3]);
                    *(u32x4*)(P + (size_t)row * 1024 + u.pn * 256 + bj * HALF + wc * 32 + 8 * fq) = w; }
                l += __shfl_xor(l, 16); l += __shfl_xor(l, 32);
                if (fq == 0) lpart[(size_t)row * 16 + u.pn * 4 + wc] = l; }
    }
};
struct SchedO {
    const char* p; const char* vt; int G, c;
    __device__ __forceinline__ bool next(int i, Unit& u) const { const int L = i * G + c; if (L >= 256) return false; u.pm = L >> 3; u.pn = L & 7; return true; }
    __device__ __forceinline__ const char* a_base(const Unit& u) const { return p + ((size_t)u.pm * BM * 1024 + (size_t)(u.pn >> 1) * 256) * 2; }
    __device__ __forceinline__ const char* b_base(const Unit& u) const { return vt + (size_t)u.pn * BM * 256 * 2; }
};
struct EpiO {
    static constexpr bool PERM = true, AFTER_DRAIN = false;
    bf16_t* O; const float* lpart;
    __device__ __forceinline__ void operator()(const f32x4 (&acc)[2][2][4][2], const Unit& u, int wr, int wc, int fr, int fq) const {
#pragma unroll
        for (int ai = 0; ai < 2; ++ai)
#pragma unroll
            for (int m = 0; m < 4; ++m) { const int row = u.pm * BM + ai * HALF + wr * 64 + m * 16 + fr;
                const f32x4 lp = *(const f32x4*)(lpart + (size_t)row * 16 + (u.pn >> 1) * 4); const float inv = 1.0f / ((lp[0] + lp[1]) + (lp[2] + lp[3]));
#pragma unroll
                for (int bj = 0; bj < 2; ++bj) { const size_t off = (size_t)row * DM + u.pn * BM + bj * HALF + wc * 32 + 8 * fq;
                    const f32x4 v0 = acc[ai][bj][m][0] * inv, v1 = acc[ai][bj][m][1] * inv;
                    u32x4 w; w.x = cvt_pk_bf16(v0[0], v0[1]); w.y = cvt_pk_bf16(v0[2], v0[3]); w.z = cvt_pk_bf16(v1[0], v1[1]); w.w = cvt_pk_bf16(v1[2], v1[3]);
                    *(u32x4*)(O + off) = w; } }
    }
};
struct EpiRes2 {
    static constexpr bool PERM = true, AFTER_DRAIN = false;
    float* out;
    __device__ __forceinline__ void operator()(const f32x4 (&acc)[2][2][4][2], const Unit& u, int wr, int wc, int fr, int fq) const {
#pragma unroll
        for (int ai = 0; ai < 2; ++ai)
#pragma unroll
            for (int m = 0; m < 4; ++m) { const int row = u.pm * BM + ai * HALF + wr * 64 + m * 16 + fr;
#pragma unroll
                for (int bj = 0; bj < 2; ++bj) { const size_t off = (size_t)row * DM + u.pn * BM + bj * HALF + wc * 32 + 8 * fq;
                    const f32x4 v0 = *(const f32x4*)(out + off) + acc[ai][bj][m][0], v1 = *(const f32x4*)(out + off + 4) + acc[ai][bj][m][1];
                    *(f32x4*)(out + off) = v0; *(f32x4*)(out + off + 4) = v1; } }
    }
};
}

__device__ __forceinline__ void p0_transpose_item(const float* W, int K, int N, bf16* WT, int row_off, const float* g, LAS float* scr, int item, int lane) {
    const int nblk = N / 32, kb = item / nblk, nb = item % nblk, k0 = 64 * kb, n0 = 32 * nb;
#pragma unroll 8
    for (int i = 0; i < 32; ++i) { const int kk = 2 * i + (lane >> 5); float v = W[(size_t)(k0 + kk) * N + n0 + (lane & 31)]; if (g) v *= g[k0 + kk]; scr[kk * 33 + (lane & 31)] = v; }
    LDS_WAIT(); asm volatile("" ::: "memory");
    const int c = lane & 7;
#pragma unroll
    for (int j = 0; j < 4; ++j) { const int n = (lane >> 3) + 8 * j; const LAS float* s = scr + (8 * c) * 33 + n;
        v4u o; o.x = pk2(s[0 * 33], s[1 * 33]); o.y = pk2(s[2 * 33], s[3 * 33]); o.z = pk2(s[4 * 33], s[5 * 33]); o.w = pk2(s[6 * 33], s[7 * 33]);
        *(v4u*)(WT + (size_t)(row_off + n0 + n) * K + k0 + 8 * c) = o; }
    LDS_WAIT(); asm volatile("" ::: "memory");
}
__device__ __forceinline__ void rms_row_to_bf16(const float* xrow, const float* g, bf16* orow, int lane) {
    const f32x4* xr = (const f32x4*)xrow + lane; const f32x4* gr = (const f32x4*)g + lane;
    f32x4 v[8]; float s = 0.f;
#pragma unroll
    for (int j = 0; j < 8; ++j) { v[j] = xr[64 * j]; s += (v[j][0] * v[j][0] + v[j][1] * v[j][1]) + (v[j][2] * v[j][2] + v[j][3] * v[j][3]); }
    const float rstd = 1.0f / sqrtf(wave_sum(s) * (1.0f / DM) + RMS_EPS);
    v2u* o8 = (v2u*)orow + lane;
#pragma unroll
    for (int j = 0; j < 8; ++j) { const f32x4 gg = gr[64 * j]; v2u o; o.x = pk2(v[j][0] * rstd * gg[0], v[j][1] * rstd * gg[1]); o.y = pk2(v[j][2] * rstd * gg[2], v[j][3] * rstd * gg[3]); o8[64 * j] = o; }
}
__device__ __forceinline__ void p0_prologue(Frame& F) {
    LAS float* scr = (LAS float*)(F.lds + F.wave * 16384);
    const int gw = F.vcu * NWAVES + F.wave, NGW = F.G * NWAVES;
    bf16* Win_t = (bf16*)(F.ws + WS_WIN); bf16* Wout_t = (bf16*)(F.ws + WS_WOUT); bf16* Wq_t = (bf16*)(F.ws + WS_WQ); bf16* Wkv_t = (bf16*)(F.ws + WS_WKV); bf16* Wo_t = (bf16*)(F.ws + WS_WO); bf16* Wg_t = (bf16*)(F.ws + WS_WG);
    constexpr int I_IN = (DM / 64) * (INC / 32), I_OUT = (MIXW / 64) * (DM / 32), I_Q = (DM / 64) * (DM / 32), I_KV = (DM / 64) * (2 * DM / 32), I_O = I_Q, I_G = 2 * NHB * 8;
    constexpr int NITEMS = I_IN + I_OUT + I_Q + I_KV + I_O + I_G;
    for (int m = gw; m < SEQ; m += NGW) rms_row_to_bf16(F.x + (size_t)m * DM, F.g_mix, (bf16*)(F.ws + WS_XN) + (size_t)m * DM, F.lane);
    for (int m = gw; m < NMEM; m += NGW) rms_row_to_bf16(F.mem + (size_t)m * DM, F.g_mem, (bf16*)(F.ws + WS_MN) + (size_t)m * DM, F.lane);
    for (int it = gw; it < NITEMS; it += NGW) {
        int r = it;
        if (r < I_IN) { p0_transpose_item(F.w_in, DM, INC, Win_t, 0, nullptr, scr, r, F.lane); continue; } r -= I_IN;
        if (r < I_OUT) { p0_transpose_item(F.w_out, MIXW, DM, Wout_t, 0, nullptr, scr, r, F.lane); continue; } r -= I_OUT;
        if (r < I_Q) { p0_transpose_item(F.w_q, DM, DM, Wq_t, 0, F.g_x, scr, r, F.lane); continue; } r -= I_Q;
        if (r < I_KV) { p0_transpose_item(F.w_kv, DM, 2 * DM, Wkv_t, 0, nullptr, scr, r, F.lane); continue; } r -= I_KV;
        if (r < I_O) { p0_transpose_item(F.w_o, DM, DM, Wo_t, 0, nullptr, scr, r, F.lane); continue; } r -= I_O;
        { const int gate = r / (NHB * 8), hh = (r / 8) % NHB, sub = r % 8;
          p0_transpose_item((gate ? F.w_i : F.w_r) + (size_t)hh * HD * HD, HD, HD, Wg_t + (size_t)hh * 256 * HD, gate * HD, nullptr, scr, sub, F.lane); }
    }
    float* rowss = (float*)(F.ws + WS_ROWSS);
    for (int i = F.vcu * NWAVES * 64 + F.tid; i < SEQ; i += F.G * NWAVES * 64) rowss[i] = 0.f;
}

__device__ __forceinline__ void conva_unit(Frame& F, int cidx) {
    const bf16* proj = (const bf16*)(F.ws + WS_PROJ); bf16* ycat = (bf16*)(F.ws + WS_YCAT);
    const int chb = (F.tid & 255) * 8, tstart = cidx * 32 + (F.tid >> 8) * 16;
    f32x4 w0[2], w1[2], w2[2], bb[2], cm2[2], cm1[2];
#pragma unroll
    for (int e = 0; e < 2; ++e) { w0[e] = *(const f32x4*)(F.caw + chb + 4 * e); w1[e] = *(const f32x4*)(F.caw + DM + chb + 4 * e); w2[e] = *(const f32x4*)(F.caw + 2 * DM + chb + 4 * e); bb[e] = *(const f32x4*)(F.cab + chb + 4 * e);
        cm2[e] = (f32x4){0.f, 0.f, 0.f, 0.f}; cm1[e] = cm2[e]; }
#pragma unroll
    for (int k = 0; k < 2; ++k) { const int tt = tstart - 2 + k;
        if (tt >= 0) { const v4u v = *(const v4u*)(proj + (size_t)tt * INC + chb), c = *(const v4u*)(proj + (size_t)tt * INC + 2 * DM + chb);
            f32x4 c0 = (f32x4){bflo(c.x) * bflo(v.x), bfhi(c.x) * bfhi(v.x), bflo(c.y) * bflo(v.y), bfhi(c.y) * bfhi(v.y)};
            f32x4 c1 = (f32x4){bflo(c.z) * bflo(v.z), bfhi(c.z) * bfhi(v.z), bflo(c.w) * bflo(v.w), bfhi(c.w) * bfhi(v.w)};
            if (k == 0) { cm2[0] = c0; cm2[1] = c1; } else { cm1[0] = c0; cm1[1] = c1; } } }
#pragma unroll 4
    for (int r = 0; r < 16; ++r) { const size_t ro = (size_t)(tstart + r) * INC + chb;
        const v4u v = *(const v4u*)(proj + ro), b = *(const v4u*)(proj + ro + DM), c = *(const v4u*)(proj + ro + 2 * DM), g = *(const v4u*)(proj + ro + 3 * DM);
        const f32x4 c0 = (f32x4){bflo(c.x) * bflo(v.x), bfhi(c.x) * bfhi(v.x), bflo(c.y) * bflo(v.y), bfhi(c.y) * bfhi(v.y)};
        const f32x4 c1 = (f32x4){bflo(c.z) * bflo(v.z), bfhi(c.z) * bfhi(v.z), bflo(c.w) * bflo(v.w), bfhi(c.w) * bfhi(v.w)};
        const f32x4 cv0 = bb[0] + w0[0] * cm2[0] + w1[0] * cm1[0] + w2[0] * c0, cv1 = bb[1] + w0[1] * cm2[1] + w1[1] * cm1[1] + w2[1] * c1;
        const f32x4 g0 = (f32x4){bflo(g.x), bfhi(g.x), bflo(g.y), bfhi(g.y)}, g1 = (f32x4){bflo(g.z), bfhi(g.z), bflo(g.w), bfhi(g.w)};
        const f32x4 b0 = (f32x4){bflo(b.x), bfhi(b.x), bflo(b.y), bfhi(b.y)}, b1 = (f32x4){bflo(b.z), bfhi(b.z), bflo(b.w), bfhi(b.w)};
        f32x4 y0, y1;
#pragma unroll
        for (int e = 0; e < 4; ++e) { y0[e] = b0[e] * cv0[e] * g0[e] * sigmoidf_(g0[e]); y1[e] = b1[e] * cv1[e] * g1[e] * sigmoidf_(g1[e]); }
        v4u o; o.x = pk2(y0[0], y0[1]); o.y = pk2(y0[2], y0[3]); o.z = pk2(y1[0], y1[1]); o.w = pk2(y1[2], y1[3]);
        *(v4u*)(ycat + (size_t)(tstart + r) * MIXW + chb) = o;
        cm2[0] = cm1[0]; cm2[1] = cm1[1]; cm1[0] = c0; cm1[1] = c1; }
}

constexpr int SC_XB = 0, SC_XBS = 272, SC_XF = 64 * 272, SC_XFS = 528, SC_GT = SC_XF + 64 * 528, SC_GTS = 272;
template <int PASS>
__device__ __forceinline__ void scan_unit(Frame& F, int c, int h) {
    LAS unsigned char* L = F.lds;
    const bf16* proj = (const bf16*)(F.ws + WS_PROJ);
    const int tid = F.tid, lane = F.lane, w = F.wave, fr = lane & 15, fq = lane >> 4, t0 = c * 64;
    const int chl = w * 16 + fr, ch = h * HD + chl;
    float hin = 0.f;
    if (PASS == 1) { const f32x2* ag = (const f32x2*)(F.ws + WS_AGG) + ch;
#pragma unroll 8
        for (int cc = 0; cc < c; ++cc) { const f32x2 v = ag[(size_t)cc * DM]; hin = v[0] * hin + v[1]; } }
    {
        const int cg8 = tid & 15, chb = h * HD + cg8 * 8;
        f32x4 wk[4][2], bb[2];
#pragma unroll
        for (int k = 0; k < 4; ++k) { wk[k][0] = *(const f32x4*)(F.cbw + k * DM + chb); wk[k][1] = *(const f32x4*)(F.cbw + k * DM + chb + 4); }
        bb[0] = *(const f32x4*)(F.cbb + chb); bb[1] = *(const f32x4*)(F.cbb + chb + 4);
#pragma unroll
        for (int it = 0; it < 2; ++it) { const int r = (tid >> 4) + it * 32, t = t0 + r;
            f32x4 a0 = bb[0], a1 = bb[1];
#pragma unroll
            for (int k = 0; k < 4; ++k) { const int tt = t - 3 + k;
                if (tt >= 0) { const v4u v = *(const v4u*)(proj + (size_t)tt * INC + 4 * DM + chb);
                    a0 += wk[k][0] * (f32x4){bflo(v.x), bfhi(v.x), bflo(v.y), bfhi(v.y)}; a1 += wk[k][1] * (f32x4){bflo(v.z), bfhi(v.z), bflo(v.w), bfhi(v.w)}; } }
            v4u o; o.x = pk2(a0[0], a0[1]); o.y = pk2(a0[2], a0[3]); o.z = pk2(a1[0], a1[1]); o.w = pk2(a1[2], a1[3]);
            *(LAS v4u*)(L + SC_XB + r * SC_XBS + cg8 * 16) = o;
            *(LAS f32x4*)(L + SC_XF + r * SC_XFS + cg8 * 32) = a0; *(LAS f32x4*)(L + SC_XF + r * SC_XFS + cg8 * 32 + 16) = a1;
            if (PASS == 1) { const v4u gv = *(const v4u*)(proj + (size_t)t * INC + 5 * DM + chb); *(LAS v4u*)(L + SC_GT + r * SC_GTS + cg8 * 16) = gv; } }
    }
    const bf16* wg = (const bf16*)(F.ws + WS_WG) + ((size_t)(h * 256 + chl)) * HD + fq * 8;
    bf16x8 br[4], bi[4];
#pragma unroll
    for (int ks = 0; ks < 4; ++ks) { br[ks] = *(const bf16x8*)(wg + ks * 32); bi[ks] = *(const bf16x8*)(wg + HD * HD + ks * 32); }
    const float brg = F.b_r[ch], big = F.b_i[ch], c8 = -8.0f * log1pf(expf(-F.lam[ch]));
    __syncthreads();
    f32x4 ar[4], ai[4];
#pragma unroll
    for (int rb = 0; rb < 4; ++rb) { ar[rb] = (f32x4){0.f, 0.f, 0.f, 0.f}; ai[rb] = ar[rb];
#pragma unroll
        for (int ks = 0; ks < 4; ++ks) { const bf16x8 a = *(const LAS bf16x8*)(L + SC_XB + (rb * 16 + fr) * SC_XBS + (ks * 32 + fq * 8) * 2);
            ar[rb] = __builtin_amdgcn_mfma_f32_16x16x32_bf16(a, br[ks], ar[rb], 0, 0, 0); ai[rb] = __builtin_amdgcn_mfma_f32_16x16x32_bf16(a, bi[ks], ai[rb], 0, 0, 0); } }
    f32x4 Pv[4], Hv[4];
#pragma unroll
    for (int rb = 0; rb < 4; ++rb) { float Pc = 1.f, Hc = 0.f;
#pragma unroll
        for (int idx = 0; idx < 4; ++idx) { const int tl = rb * 16 + fq * 4 + idx;
            const float xc = *(const LAS float*)(L + SC_XF + tl * SC_XFS + chl * 4);
            const float r = sigmoidf_(ar[rb][idx] + brg), ig = sigmoidf_(ai[rb][idx] + big);
            const float la = c8 * r, a = expf(la); float mult = sqrtf(-expm1f(2.0f * la)); if (t0 + tl == 0) mult = 1.0f;
            const float uu = mult * ig * xc;
            Hc = a * Hc + uu; Pc *= a; Pv[rb][idx] = Pc; Hv[rb][idx] = Hc; } }
    float hcar = hin, Pchunk = 1.f;
#pragma unroll
    for (int rb = 0; rb < 4; ++rb) {
        float Pt = Pv[rb][3], Ht = Hv[rb][3];
        float Pp = __shfl_up(Pt, 16), Hp = __shfl_up(Ht, 16); if (fq >= 1) { Ht = Pt * Hp + Ht; Pt = Pt * Pp; }
        Pp = __shfl_up(Pt, 32); Hp = __shfl_up(Ht, 32); if (fq >= 2) { Ht = Pt * Hp + Ht; Pt = Pt * Pp; }
        float Pe = __shfl_up(Pt, 16), He = __shfl_up(Ht, 16); if (fq == 0) { Pe = 1.f; He = 0.f; }
        const float Ptot = __shfl(Pt, fr + 48), Htot = __shfl(Ht, fr + 48);
        if (PASS == 1) { const float hent = Pe * hcar + He;
#pragma unroll
            for (int idx = 0; idx < 4; ++idx) { const int tl = rb * 16 + fq * 4 + idx; const float hv = Pv[rb][idx] * hent + Hv[rb][idx];
                LAS unsigned short* gp = (LAS unsigned short*)(L + SC_GT + tl * SC_GTS + chl * 2);
                const float g = __builtin_bit_cast(float, (unsigned)(*gp) << 16); const float y = hv * g * sigmoidf_(g);
                *gp = (unsigned short)(pk2(y, 0.f) & 0xffffu); } }
        hcar = Ptot * hcar + Htot; Pchunk *= Ptot;
    }
    if (PASS == 0) { if (fq == 0) *((f32x2*)(F.ws + WS_AGG) + (size_t)c * DM + ch) = (f32x2){Pchunk, hcar}; __syncthreads(); }
    else { __syncthreads();
        bf16* ycat = (bf16*)(F.ws + WS_YCAT);
#pragma unroll
        for (int it = 0; it < 2; ++it) { const int r = (tid >> 4) + it * 32, cg8 = tid & 15;
            *(v4u*)(ycat + (size_t)(t0 + r) * MIXW + DM + h * HD + cg8 * 8) = *(const LAS v4u*)(L + SC_GT + r * SC_GTS + cg8 * 16); }
        __syncthreads(); }
}

__device__ __forceinline__ void final_norm_row(float* row, const float* g, int lane) {
    f32x4* xr = (f32x4*)row + lane; const f32x4* gr = (const f32x4*)g + lane;
    f32x4 v[8]; float s = 0.f;
#pragma unroll
    for (int j = 0; j < 8; ++j) { v[j] = xr[64 * j]; s += (v[j][0] * v[j][0] + v[j][1] * v[j][1]) + (v[j][2] * v[j][2] + v[j][3] * v[j][3]); }
    const float rstd = 1.0f / sqrtf(wave_sum(s) * (1.0f / DM) + RMS_EPS);
#pragma unroll
    for (int j = 0; j < 8; ++j) xr[64 * j] = v[j] * rstd * gr[64 * j];
}

__global__ void __launch_bounds__(NWAVES * 64, 2) hymba_fwd(Args args) {
    extern __shared__ __attribute__((aligned(16))) unsigned char lds[];
    cg::grid_group grid = cg::this_grid();
    Frame F;
    F.lds = (LAS unsigned char*)lds;
    F.tid = threadIdx.x; F.lane = F.tid & 63; F.wave = __builtin_amdgcn_readfirstlane(F.tid >> 6);
    F.G = gridDim.x; { const int bx = blockIdx.x; F.vcu = (F.G % 8 == 0) ? (bx % 8) * (F.G / 8) + bx / 8 : bx; }
    F.x = args.in[0]; F.mem = args.in[1]; F.g_mix = args.in[2]; F.w_in = args.in[3]; F.caw = args.in[4]; F.cab = args.in[5]; F.cbw = args.in[6]; F.cbb = args.in[7];
    F.w_r = args.in[8]; F.b_r = args.in[9]; F.w_i = args.in[10]; F.b_i = args.in[11]; F.lam = args.in[12]; F.w_out = args.in[13]; F.g_x = args.in[14]; F.g_mem = args.in[15];
    F.w_q = args.in[16]; F.w_kv = args.in[17]; F.w_o = args.in[18]; F.g_f = args.in[19]; F.out = args.out; F.ws = args.ws;
    unsigned char* ws = args.ws;
    const int lo = args.ph_lo, hi = args.ph_hi;
#define IN(k) (lo <= (k) && (k) < hi)
#define SEAM(k) do { if (IN(k) && IN((k) + 1)) grid.sync(); } while (0)

    if (IN(0)) { p0_prologue(F); }
    SEAM(0);
    if (IN(1)) {
        { pg8::Gemm g{DM, DM, DM}; pg8::SchedStd S; S.init(ws + WS_XN, DM, ws + WS_WIN, DM, SEQ, INC, F.G, (int)blockIdx.x);
          pg8::EpiProj E{(pg8::bf16_t*)(ws + WS_PROJ), INC};
          pg8::gemm_phase<pg8::EpiProj, pg8::SchedStd, true>(F.lds, g, S, E); }
        { pg8::Gemm g{DM, DM, DM}; pg8::SchedKV S{(const char*)(ws + WS_MN), (const char*)(ws + WS_WKV), F.G, (int)blockIdx.x};
          pg8::EpiKV E{(pg8::bf16_t*)(ws + WS_KB), (pg8::bf16_t*)(ws + WS_VT)};
          pg8::gemm_phase<pg8::EpiKV, pg8::SchedKV, true>(F.lds, g, S, E); }
    }
    SEAM(1);
    if (IN(2)) {
        for (int u = F.vcu; u < SEQ / 32; u += F.G) conva_unit(F, u);
        for (int u = F.vcu; u < 128 * NHB; u += F.G) scan_unit<0>(F, u >> 4, u & 15);
    }
    SEAM(2);
    if (IN(3)) {
        for (int u = F.vcu; u < 128 * NHB; u += F.G) scan_unit<1>(F, u >> 4, u & 15);
    }
    SEAM(3);
    if (IN(4)) {
        pg8::Gemm g{MIXW, MIXW, MIXW}; pg8::SchedStd S; S.init(ws + WS_YCAT, MIXW, ws + WS_WOUT, MIXW, SEQ, DM, F.G, (int)blockIdx.x);
        pg8::EpiRes1 E{F.x, F.out, (pg8::bf16_t*)(ws + WS_H1B), (float*)(ws + WS_ROWSS)};
        pg8::gemm_phase<pg8::EpiRes1, pg8::SchedStd, true>(F.lds, g, S, E);
    }
    SEAM(4);
    if (IN(5)) {
        pg8::Gemm g{DM, DM, DM}; pg8::SchedStd S; S.init(ws + WS_H1B, DM, ws + WS_WQ, DM, SEQ, DM, F.G, (int)blockIdx.x);
        pg8::EpiQ E{(pg8::bf16_t*)(ws + WS_Q), (const float*)(ws + WS_ROWSS), 0.04419417382415922f * 1.4426950408889634f};
        pg8::gemm_phase<pg8::EpiQ, pg8::SchedStd, true>(F.lds, g, S, E);
    }
    SEAM(5);
    if (IN(6)) {
        pg8::Gemm g{DM, DM, XHD}; pg8::SchedS S{(const char*)(ws + WS_Q), (const char*)(ws + WS_KB), F.G, (int)blockIdx.x};
        pg8::EpiSoftmax E{(pg8::bf16_t*)(ws + WS_P), (float*)(ws + WS_LP)};
        pg8::gemm_phase<pg8::EpiSoftmax, pg8::SchedS, false>(F.lds, g, S, E);
    }
    SEAM(6);
    if (IN(7)) {
        pg8::Gemm g{1024, 256, 256}; pg8::SchedO S{(const char*)(ws + WS_P), (const char*)(ws + WS_VT), F.G, (int)blockIdx.x};
        pg8::EpiO E{(pg8::bf16_t*)(ws + WS_O), (const float*)(ws + WS_LP)};
        pg8::gemm_phase<pg8::EpiO, pg8::SchedO, true>(F.lds, g, S, E);
    }
    SEAM(7);
    if (IN(8)) {
        pg8::Gemm g{DM, DM, DM}; pg8::SchedStd S; S.init(ws + WS_O, DM, ws + WS_WO, DM, SEQ, DM, F.G, (int)blockIdx.x);
        pg8::EpiRes2 E{F.out};
        pg8::gemm_phase<pg8::EpiRes2, pg8::SchedStd, true>(F.lds, g, S, E);
    }
    SEAM(8);
    if (IN(9)) {
        const int gw = F.vcu * NWAVES + F.wave, NGW = F.G * NWAVES;
        for (int m = gw; m < SEQ; m += NGW) final_norm_row(F.out + (size_t)m * DM, F.g_f, F.lane);
    }
#undef IN
#undef SEAM
}

extern "C" void kernel_launch(void* const* d_in, const int* in_sizes, int n_in, void* d_out, int out_size, void* d_ws, size_t ws_size, hipStream_t stream) {
    static int grid = 0;
    if (grid == 0) {
        if (n_in != 20 || out_size != SEQ * DM || ws_size < WS_END) { fprintf(stderr, "kernel_launch: unexpected shapes (n_in %d out %d ws %zu)\n", n_in, out_size, ws_size); grid = -1; return; }
        int dev = 0, cus = 0, per_cu = 0;
        if (hipGetDevice(&dev) != hipSuccess || hipDeviceGetAttribute(&cus, hipDeviceAttributeMultiprocessorCount, dev) != hipSuccess) { grid = -1; return; }
        if (hipFuncSetAttribute((const void*)hymba_fwd, hipFuncAttributeMaxDynamicSharedMemorySize, LDS_BYTES) != hipSuccess) { fprintf(stderr, "kernel_launch: hipFuncSetAttribute failed\n"); grid = -1; return; }
        if (hipOccupancyMaxActiveBlocksPerMultiprocessor(&per_cu, (const void*)hymba_fwd, NWAVES * 64, LDS_BYTES) != hipSuccess || per_cu < 1) { fprintf(stderr, "kernel_launch: occupancy query says %d\n", per_cu); }
        (void)hipGetLastError();
        grid = cus;
    }
    if (grid < 0) return;
    Args a{};
    for (int i = 0; i < 20; ++i) a.in[i] = (const float*)d_in[i];
    a.out = (float*)d_out; a.ws = (unsigned char*)d_ws;
#if MK_N_LAUNCHES == 1
    a.ph_lo = 0; a.ph_hi = N_PHASES;
    void* kargs[] = {&a};
    hipError_t e = hipLaunchCooperativeKernel((const void*)hymba_fwd, dim3(grid), dim3(NWAVES * 64), kargs, LDS_BYTES, stream);
    if (e != hipSuccess) fprintf(stderr, "kernel_launch: cooperative launch failed: %s\n", hipGetErrorString(e));
#else
    for (int p = 0; p < N_PHASES; ++p) {
        a.ph_lo = p; a.ph_hi = p + 1;
        void* kargs[] = {&a};
        hipError_t e = hipLaunchCooperativeKernel((const void*)hymba_fwd, dim3(grid), dim3(NWAVES * 64), kargs, LDS_BYTES, stream);
        if (e != hipSuccess) { fprintf(stderr, "kernel_launch: launch %d failed: %s\n", p, hipGetErrorString(e)); break; }
    }
#endif
}
```

```cpp
#include <hip/hip_runtime.h>
#include <hip/hip_cooperative_groups.h>
#include <cstdio>
#include <cstdint>
namespace cg = cooperative_groups;

#ifndef MK_N_LAUNCHES
#define MK_N_LAUNCHES 1
#endif

namespace pg8 {
#define PG8_LAS __attribute__((address_space(3)))
typedef unsigned short bf16_t;
typedef short bf16x8 __attribute__((ext_vector_type(8)));
typedef float f32x4 __attribute__((ext_vector_type(4)));
typedef unsigned u32x4 __attribute__((ext_vector_type(4)));
constexpr int BM = 256, BK = 64, HALF = 128, HTB = HALF * BK * 2, STAGE_BYTES = 8 * HTB, NXCD = 8, WGM = 8;

__host__ __device__ __forceinline__ int lds_byte(int r, int c) { const int st = (r >> 4) * 2 + (c >> 5), rr = r & 15, cc = c & 31, ob = rr * 64 + cc * 2; return st * 1024 + (ob ^ (((ob >> 9) & 1) << 5)); }
__host__ __device__ __forceinline__ void stage_rc(int b, int& R, int& C) { const int st = b / 1024, sb = b % 1024, swz = sb ^ (((sb >> 9) & 1) << 5); R = (st >> 1) * 16 + swz / 64; C = (st & 1) * 32 + (swz % 64) / 2; }
__host__ __device__ __forceinline__ int perm32(int rho) { const int n = rho >> 4, i = rho & 15; return 8 * (i >> 2) + 4 * n + (i & 3); }

struct Unit { int pm, pn; };
struct Gemm { int lda, ldb, K; };

__device__ __forceinline__ unsigned cvt_pk_bf16(float lo, float hi) { unsigned r; asm volatile("v_cvt_pk_bf16_f32 %0, %1, %2" : "=v"(r) : "v"(lo), "v"(hi)); return r; }

struct SchedStd {
    const char* A; const char* B; size_t strideA, strideB;
    int nM, nN, nwg, G, c;
    __device__ __forceinline__ void init(const void* A_, int lda, const void* B_, int ldb, int M, int N, int G_, int c_) {
        A = (const char*)A_; B = (const char*)B_; strideA = (size_t)BM * lda * 2; strideB = (size_t)BM * ldb * 2; nM = M / BM; nN = N / BM; nwg = nM * nN; G = G_; c = c_; }
    __device__ __forceinline__ bool next(int i, Unit& u) const {
        const long L = (long)i * G + c; if (L >= nwg) return false;
        int wgid = (int)L; { const int q = nwg / NXCD, r = nwg % NXCD, xcd = wgid % NXCD, off = wgid / NXCD; wgid = (xcd < r ? xcd * (q + 1) : r * (q + 1) + (xcd - r) * q) + off; }
        const int nig = WGM * nN, gid = wgid / nig, fm = gid * WGM, gsz = (nM - fm) < WGM ? (nM - fm) : WGM;
        u.pm = fm + ((wgid % nig) % gsz); u.pn = (wgid % nig) / gsz; return true;
    }
    __device__ __forceinline__ const char* a_base(const Unit& u) const { return A + (size_t)u.pm * strideA; }
    __device__ __forceinline__ const char* b_base(const Unit& u) const { return B + (size_t)u.pn * strideB; }
};

template <class Epi, class Sched, bool ALIGN_EPI>
__device__ __forceinline__ void gemm_phase(PG8_LAS unsigned char* lds, const Gemm g, const Sched& S, const Epi& E) {
    const int tid = threadIdx.x, wid = __builtin_amdgcn_readfirstlane(tid >> 6), lane = tid & 63, wr = wid >> 2, wc = wid & 3, fr = lane & 15, fq = lane >> 4;
    const int K = g.K, nt = K / BK;
    unsigned voffA[2], voffB[2];
#pragma unroll
    for (int i = 0; i < 2; ++i) { int R, C; stage_rc(tid * 16 + i * 8192, R, C); const int Rb = Epi::PERM ? ((R & ~31) + perm32(R & 31)) : R;
        voffA[i] = (unsigned)(R * g.lda + C) * 2u; voffB[i] = (unsigned)(Rb * g.ldb + C) * 2u; }
    const size_t kstep = (size_t)(BK * 2);
    const size_t hA = (size_t)HALF * g.lda * 2, hB = (size_t)HALF * g.ldb * 2;
    const unsigned ldsw = (unsigned)wid * 1024u;
    const int aoff = lds_byte(wr * 64 + fr, fq * 8), boff = lds_byte(wc * 32 + fr, fq * 8);
#define PG8_SA(b, h) (((b) * 2 + (h)) * HTB)
#define PG8_SB(b, h) ((4 + (b) * 2 + (h)) * HTB)
#define PG8_STAGE(bufoff, gbase, voff) do { _Pragma("unroll") for (int _i = 0; _i < 2; ++_i) \
        __builtin_amdgcn_global_load_lds((const unsigned*)((const char*)(gbase) + (voff)[_i]), (PG8_LAS unsigned*)(lds + (bufoff) + ldsw + _i * 8192), 16, 0, 0); } while (0)
#define PG8_LDA(dst, b, h) do { _Pragma("unroll") for (int m = 0; m < 4; ++m) _Pragma("unroll") for (int k = 0; k < 2; ++k) dst[m][k] = *(const PG8_LAS bf16x8*)(lds + PG8_SA(b, h) + aoff + m * 2048 + k * 1024); } while (0)
#define PG8_LDB(dst, b, h) do { _Pragma("unroll") for (int n = 0; n < 2; ++n) _Pragma("unroll") for (int k = 0; k < 2; ++k) dst[n][k] = *(const PG8_LAS bf16x8*)(lds + PG8_SB(b, h) + boff + n * 2048 + k * 1024); } while (0)
#define PG8_MMA(ai, bj, At, Bt) do { __builtin_amdgcn_s_setprio(1); _Pragma("unroll") for (int m = 0; m < 4; ++m) _Pragma("unroll") for (int n = 0; n < 2; ++n) _Pragma("unroll") for (int k = 0; k < 2; ++k) \
        acc[ai][bj][m][n] = __builtin_amdgcn_mfma_f32_16x16x32_bf16(Bt[n][k], At[m][k], acc[ai][bj][m][n], 0, 0, 0); __builtin_amdgcn_s_setprio(0); } while (0)
#define PG8_WAIT_V(n) asm volatile("s_waitcnt vmcnt(" #n ")" ::: "memory")
#define PG8_WAIT_L(n) asm volatile("s_waitcnt lgkmcnt(" #n ")" ::: "memory")
#define PG8_BAR __builtin_amdgcn_s_barrier()
#define PG8_SCHED __builtin_amdgcn_sched_barrier(0)
    Unit cur, nxt; int ui = 0;
    if (!S.next(0, cur)) return;
    f32x4 acc[2][2][4][2];
#pragma unroll
    for (int a = 0; a < 2; ++a)
#pragma unroll
        for (int b = 0; b < 2; ++b)
#pragma unroll
            for (int m = 0; m < 4; ++m)
#pragma unroll
                for (int n = 0; n < 2; ++n) acc[a][b][m][n] = (f32x4){0.f, 0.f, 0.f, 0.f};
    bf16x8 At[4][2], B0[2][2], B1[2][2];
    const char* cA = S.a_base(cur); const char* cB = S.b_base(cur);
    PG8_STAGE(PG8_SB(0, 0), cB, voffB); PG8_STAGE(PG8_SB(0, 1), cB + hB, voffB); PG8_STAGE(PG8_SA(0, 0), cA, voffA); PG8_STAGE(PG8_SA(0, 1), cA + hA, voffA);
    if (wr == 1) PG8_BAR;
    PG8_WAIT_V(2); PG8_BAR;
    PG8_STAGE(PG8_SB(1, 0), cB + kstep, voffB); PG8_STAGE(PG8_SA(1, 0), cA + kstep, voffA); PG8_STAGE(PG8_SB(1, 1), cB + hB + kstep, voffB);
    PG8_WAIT_V(6); PG8_BAR;
    for (;;) {
        const bool has_next = S.next(ui + 1, nxt);
        const char* nA = has_next ? S.a_base(nxt) : cA; const char* nB = has_next ? S.b_base(nxt) : cB;
        for (int t = 0; t < nt; t += 2) {
            const bool last = (t == nt - 2);
            const char* a1 = cA + (size_t)(t + 1) * kstep;
            const char* a2 = last ? nA : cA + (size_t)(t + 2) * kstep; const char* b2 = last ? nB : cB + (size_t)(t + 2) * kstep;
            const char* a3 = a2 + kstep; const char* b3 = b2 + kstep;
            PG8_LDB(B0, 0, 0); PG8_LDB(B1, 0, 1); PG8_SCHED; PG8_LDA(At, 0, 0); PG8_STAGE(PG8_SA(1, 1), a1 + hA, voffA);
            PG8_WAIT_V(8); PG8_WAIT_L(0); PG8_BAR; PG8_MMA(0, 0, At, B0); PG8_MMA(0, 1, At, B1); PG8_BAR; PG8_SCHED;
            PG8_LDA(At, 0, 1); PG8_STAGE(PG8_SB(0, 0), b2, voffB); PG8_STAGE(PG8_SB(0, 1), b2 + hB, voffB); PG8_STAGE(PG8_SA(0, 0), a2, voffA);
            PG8_WAIT_V(8); PG8_WAIT_L(0); PG8_BAR; PG8_MMA(1, 0, At, B0); PG8_MMA(1, 1, At, B1); PG8_BAR; PG8_SCHED;
            PG8_LDB(B0, 1, 0); PG8_LDB(B1, 1, 1); PG8_SCHED; PG8_LDA(At, 1, 0); PG8_STAGE(PG8_SA(0, 1), a2 + hA, voffA);
            PG8_WAIT_V(8); PG8_WAIT_L(0); PG8_BAR; PG8_MMA(0, 0, At, B0); PG8_MMA(0, 1, At, B1); PG8_BAR; PG8_SCHED;
            PG8_LDA(At, 1, 1); PG8_STAGE(PG8_SB(1, 0), b3, voffB); PG8_STAGE(PG8_SB(1, 1), b3 + hB, voffB); PG8_STAGE(PG8_SA(1, 0), a3, voffA);
            PG8_WAIT_V(8); PG8_WAIT_L(0); PG8_BAR; PG8_MMA(1, 0, At, B0); PG8_MMA(1, 1, At, B1); PG8_BAR; PG8_SCHED;
        }
        if constexpr (ALIGN_EPI) { if (wr == 0) PG8_BAR; }
        if constexpr (!Epi::AFTER_DRAIN) { E(acc, cur, wr, wc, fr, fq); }
        if (!has_next) break;
#pragma unroll
        for (int a = 0; a < 2; ++a)
#pragma unroll
            for (int b = 0; b < 2; ++b)
#pragma unroll
                for (int m = 0; m < 4; ++m)
#pragma unroll
                    for (int n = 0; n < 2; ++n) acc[a][b][m][n] = (f32x4){0.f, 0.f, 0.f, 0.f};
        cur = nxt; cA = nA; cB = nB; ++ui;
        if constexpr (ALIGN_EPI) { if (wr == 1) PG8_BAR; }
    }
    PG8_WAIT_V(0);
    if constexpr (!ALIGN_EPI) { if (wr == 0) PG8_BAR; }
    PG8_BAR;
    if constexpr (Epi::AFTER_DRAIN) { E.fused(acc, cur, wr, wc, fr, fq, lds, wid, lane); }
#undef PG8_SA
#undef PG8_SB
#undef PG8_STAGE
#undef PG8_LDA
#undef PG8_LDB
#undef PG8_MMA
#undef PG8_WAIT_V
#undef PG8_WAIT_L
#undef PG8_BAR
#undef PG8_SCHED
}
}

constexpr int NWAVES = 8;
constexpr int SEQ = 8192, DM = 2048, NMEM = 256, INC = 12288, MIXW = 4096, NHB = 16, HD = 128, XH = 4, XHD = 512;
constexpr float RMS_EPS = 1e-6f;
constexpr int N_PHASES = 10;

constexpr size_t MiB = 1u << 20;
constexpr size_t WS_ROWSS = 0;
constexpr size_t WS_BAR = 65536;
constexpr size_t CTL_ZERO_BYTES = 131072;
constexpr size_t WS_WG = 1 * MiB;
constexpr size_t WS_MN = 2 * MiB;
constexpr size_t WS_KB = 3 * MiB;
constexpr size_t WS_VT = 4 * MiB;
constexpr size_t WS_AGG = 5 * MiB;
constexpr size_t WS_LP = 7 * MiB;
constexpr size_t WS_WOUT = 8 * MiB;
constexpr size_t WS_WQ = 24 * MiB;
constexpr size_t WS_WO = 32 * MiB;
constexpr size_t WS_WIN = 40 * MiB;
constexpr size_t WS_WKV = 88 * MiB;
constexpr size_t WS_XN = 104 * MiB;
constexpr size_t WS_YCAT = 40 * MiB;
constexpr size_t WS_PROJ = 136 * MiB;
constexpr size_t WS_H1B = 136 * MiB;
constexpr size_t WS_Q = 168 * MiB;
constexpr size_t WS_P = 200 * MiB;
constexpr size_t WS_O = 216 * MiB;
constexpr size_t WS_END = 328 * MiB;

constexpr int RING_BYTES = 131072;
constexpr int LDS_BYTES = 147456;

#define GAS __attribute__((address_space(1)))
#define LAS __attribute__((address_space(3)))
typedef unsigned short bf16;
typedef unsigned v4u __attribute__((ext_vector_type(4)));
typedef unsigned v2u __attribute__((ext_vector_type(2)));
typedef float f32x4 __attribute__((ext_vector_type(4)));
typedef float f32x2 __attribute__((ext_vector_type(2)));
typedef short bf16x8 __attribute__((ext_vector_type(8)));
#define LDS_WAIT() asm volatile("s_waitcnt lgkmcnt(0)" ::: "memory")

__device__ __forceinline__ unsigned pk2(float lo, float hi) { return pg8::cvt_pk_bf16(lo, hi); }
__device__ __forceinline__ float bflo(unsigned v) { return __builtin_bit_cast(float, v << 16); }
__device__ __forceinline__ float bfhi(unsigned v) { return __builtin_bit_cast(float, v & 0xffff0000u); }
__device__ __forceinline__ float wave_sum(float v) {
#pragma unroll
    for (int o = 1; o < 64; o <<= 1) v += __shfl_xor(v, o);
    return v;
}
__device__ __forceinline__ float sigmoidf_(float x) { return 1.0f / (1.0f + __expf(-x)); }


#define XB_TMO      128
#define XB_XCNT(j)  (256  + 64 * (j))
#define XB_XSUB(j)  (1280 + 64 * (j))
#define XB_XGEN(j)  (2304 + 64 * (j))
#define XB_TOP      3328
#define XB_TOPGEN   3392
#define XCD_BAR_WORDS 3456
#define XB_SPIN_CAP (1u << 18)
__device__ __forceinline__ unsigned xb_ld(unsigned* p)              { return __hip_atomic_load(p, __ATOMIC_RELAXED, __HIP_MEMORY_SCOPE_AGENT); }
__device__ __forceinline__ unsigned xb_add(unsigned* p, unsigned v) { return __hip_atomic_fetch_add(p, v, __ATOMIC_RELAXED, __HIP_MEMORY_SCOPE_AGENT); }
__device__ __forceinline__ unsigned xb_xcc_id() { return (unsigned)__builtin_amdgcn_s_getreg((3 << 11) | 20) & 0xFu; }
#define XB_SPIN(cond, bar) do { unsigned _sp = 0; while (cond) { __builtin_amdgcn_s_sleep(1); \
    if ((++_sp & 255u) == 0u) { if (xb_ld(&(bar)[XB_TMO])) break; if (_sp > XB_SPIN_CAP) { atomicAdd(&(bar)[XB_TMO], 1u); break; } } } } while (0)
struct XcdBarrier { unsigned* bar; unsigned x; volatile LAS unsigned* st; };
__device__ __forceinline__ XcdBarrier xcd_barrier_post(unsigned* bar, volatile LAS unsigned* st) {
    XcdBarrier b; b.bar = bar; b.x = xb_xcc_id(); b.st = st;
    if (threadIdx.x == 0) (void)xb_add(&bar[XB_XCNT(b.x)], 1u);
    return b;
}
__device__ __forceinline__ void xcd_barrier_complete(unsigned* bar, unsigned x, unsigned& nloc, unsigned& nx) {
    const unsigned G = gridDim.x * gridDim.y * gridDim.z;
    unsigned sum, cnt, mine, sp = 0u;
    for (;;) {
        sum = 0u; cnt = 0u; mine = 0u;
#pragma unroll
        for (unsigned j = 0; j < 16; ++j) { const unsigned c = xb_ld(&bar[XB_XCNT(j)]); sum += c; cnt += (c > 0u) ? 1u : 0u; mine = (j == x) ? c : mine; }
        if (sum == G) break;
        __builtin_amdgcn_s_sleep(1);
        if ((++sp & 255u) == 0u) { if (xb_ld(&bar[XB_TMO])) break; if (sp > XB_SPIN_CAP) { atomicAdd(&bar[XB_TMO], 1u); break; } }
    }
    nloc = mine > 0u ? mine : 1u; nx = cnt > 0u ? cnt : 1u;
}
__device__ __forceinline__ void xcd_barrier(const XcdBarrier& b) {
    asm volatile("s_waitcnt vmcnt(0)" ::: "memory");
    __syncthreads();
    if (threadIdx.x == 0) {
        unsigned* bar = b.bar;
        __builtin_amdgcn_s_waitcnt(0);
        unsigned nloc = b.st[0], nx = b.st[1];
        if (nloc == 0u) { xcd_barrier_complete(bar, b.x, nloc, nx); b.st[0] = nloc; b.st[1] = nx; }
        const unsigned old = xb_add(&bar[XB_XSUB(b.x)], 1u);
        const unsigned gen = old / nloc;
        if (old + 1u == (gen + 1u) * nloc) {
            __builtin_amdgcn_fence(__ATOMIC_RELEASE, "agent");
            asm volatile("s_waitcnt vmcnt(0)" ::: "memory");
            const unsigned og = xb_add(&bar[XB_TOP], 1u);
            const unsigned tg = og / nx;
            if (og + 1u == (tg + 1u) * nx) xb_add(&bar[XB_TOPGEN], 1u);
            else XB_SPIN(xb_ld(&bar[XB_TOPGEN]) == tg, bar);
            __builtin_amdgcn_fence(__ATOMIC_ACQUIRE, "agent");
            xb_add(&bar[XB_XGEN(b.x)], 1u);
            asm volatile("s_waitcnt vmcnt(0)" ::: "memory");
        } else {
            XB_SPIN(xb_ld(&bar[XB_XGEN(b.x)]) == gen, bar);
            __builtin_amdgcn_fence(__ATOMIC_ACQUIRE, "agent");
            asm volatile("s_waitcnt vmcnt(0)" ::: "memory");
        }
    }
    __syncthreads();
}

struct Args {
    const float* in[20]; float* out; unsigned char* ws; int ph_lo, ph_hi;
};

struct Frame {
    LAS unsigned char* lds;
    int tid, lane, wave, vcu, G;
    const float *x, *mem, *g_mix, *w_in, *caw, *cab, *cbw, *cbb, *w_r, *b_r, *w_i, *b_i, *lam, *w_out, *g_x, *g_mem, *w_q, *w_kv, *w_o, *g_f;
    float* out; unsigned char* ws;
};

namespace pg8 {
__device__ __forceinline__ void store_tile_bf16(const f32x4 (&acc)[2][2][4][2], bf16_t* tile, int ldc, int wr, int wc, int fr, int fq) {
#pragma unroll
    for (int ai = 0; ai < 2; ++ai)
#pragma unroll
        for (int m = 0; m < 4; ++m) { bf16_t* rowp = tile + (size_t)(ai * HALF + wr * 64 + m * 16 + fr) * ldc + wc * 32 + 8 * fq;
#pragma unroll
            for (int bj = 0; bj < 2; ++bj) { const f32x4 v0 = acc[ai][bj][m][0], v1 = acc[ai][bj][m][1];
                u32x4 w; w.x = cvt_pk_bf16(v0[0], v0[1]); w.y = cvt_pk_bf16(v0[2], v0[3]); w.z = cvt_pk_bf16(v1[0], v1[1]); w.w = cvt_pk_bf16(v1[2], v1[3]);
                *(u32x4*)(rowp + bj * HALF) = w; } }
}
struct EpiProj {
    static constexpr bool PERM = true, AFTER_DRAIN = false;
    bf16_t* O; int ldc;
    __device__ __forceinline__ void operator()(const f32x4 (&acc)[2][2][4][2], const Unit& u, int wr, int wc, int fr, int fq) const {
        store_tile_bf16(acc, O + (size_t)u.pm * BM * ldc + (size_t)u.pn * BM, ldc, wr, wc, fr, fq); }
};
struct SchedKV {
    const char* mn; const char* wkv; int G, c;
    __device__ __forceinline__ bool next(int i, Unit& u) const { const int L = i * G + c; if (L >= 16) return false; u.pm = L; u.pn = 0; return true; }
    __device__ __forceinline__ const char* a_base(const Unit& u) const { return u.pm < 8 ? mn : wkv + (size_t)(2048 + (u.pm - 8) * 256) * 2048 * 2; }
    __device__ __forceinline__ const char* b_base(const Unit& u) const { return u.pm < 8 ? wkv + (size_t)(u.pm * 256) * 2048 * 2 : mn; }
};
struct EpiKV {
    static constexpr bool PERM = true, AFTER_DRAIN = false;
    bf16_t* Kb; bf16_t* Vt;
    __device__ __forceinline__ void operator()(const f32x4 (&acc)[2][2][4][2], const Unit& u, int wr, int wc, int fr, int fq) const {
        if (u.pm < 8) store_tile_bf16(acc, Kb + (size_t)u.pm * BM, 2048, wr, wc, fr, fq);
        else store_tile_bf16(acc, Vt + (size_t)(u.pm - 8) * BM * 256, 256, wr, wc, fr, fq); }
};
struct EpiRes1 {
    static constexpr bool PERM = true, AFTER_DRAIN = false;
    const float* x; float* h1; bf16_t* h1b; float* rowss;
    __device__ __forceinline__ void operator()(const f32x4 (&acc)[2][2][4][2], const Unit& u, int wr, int wc, int fr, int fq) const {
#pragma unroll
        for (int ai = 0; ai < 2; ++ai)
#pragma unroll
            for (int m = 0; m < 4; ++m) { const int row = u.pm * BM + ai * HALF + wr * 64 + m * 16 + fr; float ss = 0.f;
#pragma unroll
                for (int bj = 0; bj < 2; ++bj) { const size_t off = (size_t)row * DM + u.pn * BM + bj * HALF + wc * 32 + 8 * fq;
                    const f32x4 v0 = *(const f32x4*)(x + off) + acc[ai][bj][m][0], v1 = *(const f32x4*)(x + off + 4) + acc[ai][bj][m][1];
                    *(f32x4*)(h1 + off) = v0; *(f32x4*)(h1 + off + 4) = v1;
                    ss += (v0[0] * v0[0] + v0[1] * v0[1]) + (v0[2] * v0[2] + v0[3] * v0[3]) + (v1[0] * v1[0] + v1[1] * v1[1]) + (v1[2] * v1[2] + v1[3] * v1[3]);
                    u32x4 w; w.x = cvt_pk_bf16(v0[0], v0[1]); w.y = cvt_pk_bf16(v0[2], v0[3]); w.z = cvt_pk_bf16(v1[0], v1[1]); w.w = cvt_pk_bf16(v1[2], v1[3]);
                    *(u32x4*)(h1b + off) = w; }
                ss += __shfl_xor(ss, 16); ss += __shfl_xor(ss, 32);
                if (fq == 0) atomicAdd(rowss + row, ss); }
    }
};
struct EpiQ {
    static constexpr bool PERM = true, AFTER_DRAIN = false;
    bf16_t* Q; const float* rowss; float c;
    __device__ __forceinline__ void operator()(const f32x4 (&acc)[2][2][4][2], const Unit& u, int wr, int wc, int fr, int fq) const {
#pragma unroll
        for (int ai = 0; ai < 2; ++ai)
#pragma unroll
            for (int m = 0; m < 4; ++m) { const int row = u.pm * BM + ai * HALF + wr * 64 + m * 16 + fr;
                const float rs = c / sqrtf(rowss[row] * (1.0f / DM) + RMS_EPS);
#pragma unroll
                for (int bj = 0; bj < 2; ++bj) { const size_t off = (size_t)row * DM + u.pn * BM + bj * HALF + wc * 32 + 8 * fq;
                    const f32x4 v0 = acc[ai][bj][m][0] * rs, v1 = acc[ai][bj][m][1] * rs;
                    u32x4 w; w.x = cvt_pk_bf16(v0[0], v0[1]); w.y = cvt_pk_bf16(v0[2], v0[3]); w.z = cvt_pk_bf16(v1[0], v1[1]); w.w = cvt_pk_bf16(v1[2], v1[3]);
                    *(u32x4*)(Q + off) = w; } }
    }
};
struct SchedS {
    const char* q; const char* kb; int G, c;
    __device__ __forceinline__ bool next(int i, Unit& u) const { const int L = i * G + c; if (L >= 128) return false; u.pm = L >> 2; u.pn = L & 3; return true; }
    __device__ __forceinline__ const char* a_base(const Unit& u) const { return q + ((size_t)u.pm * BM * DM + (size_t)u.pn * XHD) * 2; }
    __device__ __forceinline__ const char* b_base(const Unit& u) const { return kb + (size_t)u.pn * XHD * 2; }
};
struct EpiSoftmax {
    static constexpr bool PERM = true, AFTER_DRAIN = true;
    bf16_t* P; float* lpart;
    __device__ __forceinline__ void fused(const f32x4 (&acc)[2][2][4][2], const Unit& u, int wr, int wc, int fr, int fq, PG8_LAS unsigned char* lds, int wid, int lane) const {
        PG8_LAS float* Pm = (PG8_LAS float*)lds;
#pragma unroll
        for (int ai = 0; ai < 2; ++ai)
#pragma unroll
            for (int m = 0; m < 4; ++m) { float mx = -3.0e38f;
#pragma unroll
                for (int bj = 0; bj < 2; ++bj)
#pragma unroll
                    for (int n = 0; n < 2; ++n) { const f32x4 v = acc[ai][bj][m][n]; mx = fmaxf(mx, fmaxf(fmaxf(v[0], v[1]), fmaxf(v[2], v[3]))); }
                mx = fmaxf(mx, __shfl_xor(mx, 16)); mx = fmaxf(mx, __shfl_xor(mx, 32));
                if (fq == 0) Pm[(ai * HALF + wr * 64 + m * 16 + fr) * 4 + wc] = mx; }
        asm volatile("s_waitcnt lgkmcnt(0)" ::: "memory"); __builtin_amdgcn_s_barrier(); asm volatile("" ::: "memory");
#pragma unroll
        for (int ai = 0; ai < 2; ++ai)
#pragma unroll
            for (int m = 0; m < 4; ++m) { const int r = ai * HALF + wr * 64 + m * 16 + fr; const int row = u.pm * BM + r;
                const f32x4 pm4 = *(const PG8_LAS f32x4*)(Pm + r * 4); const float mx = fmaxf(fmaxf(pm4[0], pm4[1]), fmaxf(pm4[2], pm4[3]));
                float l = 0.f;
#pragma unroll
                for (int bj = 0; bj < 2; ++bj) { f32x4 v0 = acc[ai][bj][m][0], v1 = acc[ai][bj][m][1];
#pragma unroll
                    for (int e = 0; e < 4; ++e) { v0[e] = __builtin_amdgcn_exp2f(v0[e] - mx); v1[e] = __builtin_amdgcn_exp2f(v1[e] - mx); }
                    l += (v0[0] + v0[1]) + (v0[2] + v0[3]) + (v1[0] + v1[1]) + (v1[2] + v1[3]);
                    u32x4 w; w.x = cvt_pk_bf16(v0[0], v0[1]); w.y = cvt_pk_bf16(v0[2], v0[3]); w.z = cvt_pk_bf16(v1[0], v1[1]); w.w = cvt_pk_bf16(v1[2], v1[3]);
                    *(u32x4*)(P + (size_t)row * 1024 + u.pn * 256 + bj * HALF + wc * 32 + 8 * fq) = w; }
                l += __shfl_xor(l, 16); l += __shfl_xor(l, 32);
                if (fq == 0) lpart[(size_t)row * 16 + u.pn * 4 + wc] = l; }
    }
};
struct SchedO {
    const char* p; const char* vt; int G, c;
    __device__ __forceinline__ bool next(int i, Unit& u) const { const int L = i * G + c; if (L >= 256) return false; u.pm = L >> 3; u.pn = L & 7; return true; }
    __device__ __forceinline__ const char* a_base(const Unit& u) const { return p + ((size_t)u.pm * BM * 1024 + (size_t)(u.pn >> 1) * 256) * 2; }
    __device__ __forceinline__ const char* b_base(const Unit& u) const { return vt + (size_t)u.pn * BM * 256 * 2; }
};
struct EpiO {
    static constexpr bool PERM = true, AFTER_DRAIN = false;
    bf16_t* O; const float* lpart;
    __device__ __forceinline__ void operator()(const f32x4 (&acc)[2][2][4][2], const Unit& u, int wr, int wc, int fr, int fq) const {
#pragma unroll
        for (int ai = 0; ai < 2; ++ai)
#pragma unroll
            for (int m = 0; m < 4; ++m) { const int row = u.pm * BM + ai * HALF + wr * 64 + m * 16 + fr;
                const f32x4 lp = *(const f32x4*)(lpart + (size_t)row * 16 + (u.pn >> 1) * 4); const float inv = 1.0f / ((lp[0] + lp[1]) + (lp[2] + lp[3]));
#pragma unroll
                for (int bj = 0; bj < 2; ++bj) { const size_t off = (size_t)row * DM + u.pn * BM + bj * HALF + wc * 32 + 8 * fq;
                    const f32x4 v0 = acc[ai][bj][m][0] * inv, v1 = acc[ai][bj][m][1] * inv;
                    u32x4 w; w.x = cvt_pk_bf16(v0[0], v0[1]); w.y = cvt_pk_bf16(v0[2], v0[3]); w.z = cvt_pk_bf16(v1[0], v1[1]); w.w = cvt_pk_bf16(v1[2], v1[3]);
                    *(u32x4*)(O + off) = w; } }
    }
};
struct EpiRes2 {
    static constexpr bool PERM = true, AFTER_DRAIN = false;
    float* out;
    __device__ __forceinline__ void operator()(const f32x4 (&acc)[2][2][4][2], const Unit& u, int wr, int wc, int fr, int fq) const {
#pragma unroll
        for (int ai = 0; ai < 2; ++ai)
#pragma unroll
            for (int m = 0; m < 4; ++m) { const int row = u.pm * BM + ai * HALF + wr * 64 + m * 16 + fr;
#pragma unroll
                for (int bj = 0; bj < 2; ++bj) { const size_t off = (size_t)row * DM + u.pn * BM + bj * HALF + wc * 32 + 8 * fq;
                    const f32x4 v0 = *(const f32x4*)(out + off) + acc[ai][bj][m][0], v1 = *(const f32x4*)(out + off + 4) + acc[ai][bj][m][1];
                    *(f32x4*)(out + off) = v0; *(f32x4*)(out + off + 4) = v1; } }
    }
};
}

__device__ __forceinline__ void p0_transpose_item(const float* W, int K, int N, bf16* WT, int row_off, const float* g, LAS float* scr, int item, int lane) {
    const int nblk = N / 32, kb = item / nblk, nb = item % nblk, k0 = 64 * kb, n0 = 32 * nb;
#pragma unroll 8
    for (int i = 0; i < 32; ++i) { const int kk = 2 * i + (lane >> 5); float v = W[(size_t)(k0 + kk) * N + n0 + (lane & 31)]; if (g) v *= g[k0 + kk]; scr[kk * 33 + (lane & 31)] = v; }
    LDS_WAIT(); asm volatile("" ::: "memory");
    const int c = lane & 7;
#pragma unroll
    for (int j = 0; j < 4; ++j) { const int n = (lane >> 3) + 8 * j; const LAS float* s = scr + (8 * c) * 33 + n;
        v4u o; o.x = pk2(s[0 * 33], s[1 * 33]); o.y = pk2(s[2 * 33], s[3 * 33]); o.z = pk2(s[4 * 33], s[5 * 33]); o.w = pk2(s[6 * 33], s[7 * 33]);
        *(v4u*)(WT + (size_t)(row_off + n0 + n) * K + k0 + 8 * c) = o; }
    LDS_WAIT(); asm volatile("" ::: "memory");
}
__device__ __forceinline__ void rms_row_to_bf16(const float* xrow, const float* g, bf16* orow, int lane) {
    const f32x4* xr = (const f32x4*)xrow + lane; const f32x4* gr = (const f32x4*)g + lane;
    f32x4 v[8]; float s = 0.f;
#pragma unroll
    for (int j = 0; j < 8; ++j) { v[j] = xr[64 * j]; s += (v[j][0] * v[j][0] + v[j][1] * v[j][1]) + (v[j][2] * v[j][2] + v[j][3] * v[j][3]); }
    const float rstd = 1.0f / sqrtf(wave_sum(s) * (1.0f / DM) + RMS_EPS);
    v2u* o8 = (v2u*)orow + lane;
#pragma unroll
    for (int j = 0; j < 8; ++j) { const f32x4 gg = gr[64 * j]; v2u o; o.x = pk2(v[j][0] * rstd * gg[0], v[j][1] * rstd * gg[1]); o.y = pk2(v[j][2] * rstd * gg[2], v[j][3] * rstd * gg[3]); o8[64 * j] = o; }
}
__device__ __forceinline__ void p0_prologue(Frame& F) {
    LAS float* scr = (LAS float*)(F.lds + F.wave * 16384);
    const int gw = F.vcu * NWAVES + F.wave, NGW = F.G * NWAVES;
    bf16* Win_t = (bf16*)(F.ws + WS_WIN); bf16* Wout_t = (bf16*)(F.ws + WS_WOUT); bf16* Wq_t = (bf16*)(F.ws + WS_WQ); bf16* Wkv_t = (bf16*)(F.ws + WS_WKV); bf16* Wo_t = (bf16*)(F.ws + WS_WO); bf16* Wg_t = (bf16*)(F.ws + WS_WG);
    constexpr int I_IN = (DM / 64) * (INC / 32), I_OUT = (MIXW / 64) * (DM / 32), I_Q = (DM / 64) * (DM / 32), I_KV = (DM / 64) * (2 * DM / 32), I_O = I_Q, I_G = 2 * NHB * 8;
    constexpr int NITEMS = I_IN + I_OUT + I_Q + I_KV + I_O + I_G;
    for (int m = gw; m < SEQ; m += NGW) rms_row_to_bf16(F.x + (size_t)m * DM, F.g_mix, (bf16*)(F.ws + WS_XN) + (size_t)m * DM, F.lane);
    for (int m = gw; m < NMEM; m += NGW) rms_row_to_bf16(F.mem + (size_t)m * DM, F.g_mem, (bf16*)(F.ws + WS_MN) + (size_t)m * DM, F.lane);
    for (int it = gw; it < NITEMS; it += NGW) {
        int r = it;
        if (r < I_IN) { p0_transpose_item(F.w_in, DM, INC, Win_t, 0, nullptr, scr, r, F.lane); continue; } r -= I_IN;
        if (r < I_OUT) { p0_transpose_item(F.w_out, MIXW, DM, Wout_t, 0, nullptr, scr, r, F.lane); continue; } r -= I_OUT;
        if (r < I_Q) { p0_transpose_item(F.w_q, DM, DM, Wq_t, 0, F.g_x, scr, r, F.lane); continue; } r -= I_Q;
        if (r < I_KV) { p0_transpose_item(F.w_kv, DM, 2 * DM, Wkv_t, 0, nullptr, scr, r, F.lane); continue; } r -= I_KV;
        if (r < I_O) { p0_transpose_item(F.w_o, DM, DM, Wo_t, 0, nullptr, scr, r, F.lane); continue; } r -= I_O;
        { const int gate = r / (NHB * 8), hh = (r / 8) % NHB, sub = r % 8;
          p0_transpose_item((gate ? F.w_i : F.w_r) + (size_t)hh * HD * HD, HD, HD, Wg_t + (size_t)hh * 256 * HD, gate * HD, nullptr, scr, sub, F.lane); }
    }
    float* rowss = (float*)(F.ws + WS_ROWSS);
    for (int i = F.vcu * NWAVES * 64 + F.tid; i < SEQ; i += F.G * NWAVES * 64) rowss[i] = 0.f;
}

__device__ __forceinline__ void conva_unit(Frame& F, int cidx) {
    const bf16* proj = (const bf16*)(F.ws + WS_PROJ); bf16* ycat = (bf16*)(F.ws + WS_YCAT);
    const int chb = (F.tid & 255) * 8, tstart = cidx * 32 + (F.tid >> 8) * 16;
    f32x4 w0[2], w1[2], w2[2], bb[2], cm2[2], cm1[2];
#pragma unroll
    for (int e = 0; e < 2; ++e) { w0[e] = *(const f32x4*)(F.caw + chb + 4 * e); w1[e] = *(const f32x4*)(F.caw + DM + chb + 4 * e); w2[e] = *(const f32x4*)(F.caw + 2 * DM + chb + 4 * e); bb[e] = *(const f32x4*)(F.cab + chb + 4 * e);
        cm2[e] = (f32x4){0.f, 0.f, 0.f, 0.f}; cm1[e] = cm2[e]; }
#pragma unroll
    for (int k = 0; k < 2; ++k) { const int tt = tstart - 2 + k;
        if (tt >= 0) { const v4u v = *(const v4u*)(proj + (size_t)tt * INC + chb), c = *(const v4u*)(proj + (size_t)tt * INC + 2 * DM + chb);
            f32x4 c0 = (f32x4){bflo(c.x) * bflo(v.x), bfhi(c.x) * bfhi(v.x), bflo(c.y) * bflo(v.y), bfhi(c.y) * bfhi(v.y)};
            f32x4 c1 = (f32x4){bflo(c.z) * bflo(v.z), bfhi(c.z) * bfhi(v.z), bflo(c.w) * bflo(v.w), bfhi(c.w) * bfhi(v.w)};
            if (k == 0) { cm2[0] = c0; cm2[1] = c1; } else { cm1[0] = c0; cm1[1] = c1; } } }
#pragma unroll 4
    for (int r = 0; r < 16; ++r) { const size_t ro = (size_t)(tstart + r) * INC + chb;
        const v4u v = *(const v4u*)(proj + ro), b = *(const v4u*)(proj + ro + DM), c = *(const v4u*)(proj + ro + 2 * DM), g = *(const v4u*)(proj + ro + 3 * DM);
        const f32x4 c0 = (f32x4){bflo(c.x) * bflo(v.x), bfhi(c.x) * bfhi(v.x), bflo(c.y) * bflo(v.y), bfhi(c.y) * bfhi(v.y)};
        const f32x4 c1 = (f32x4){bflo(c.z) * bflo(v.z), bfhi(c.z) * bfhi(v.z), bflo(c.w) * bflo(v.w), bfhi(c.w) * bfhi(v.w)};
        const f32x4 cv0 = bb[0] + w0[0] * cm2[0] + w1[0] * cm1[0] + w2[0] * c0, cv1 = bb[1] + w0[1] * cm2[1] + w1[1] * cm1[1] + w2[1] * c1;
        const f32x4 g0 = (f32x4){bflo(g.x), bfhi(g.x), bflo(g.y), bfhi(g.y)}, g1 = (f32x4){bflo(g.z), bfhi(g.z), bflo(g.w), bfhi(g.w)};
        const f32x4 b0 = (f32x4){bflo(b.x), bfhi(b.x), bflo(b.y), bfhi(b.y)}, b1 = (f32x4){bflo(b.z), bfhi(b.z), bflo(b.w), bfhi(b.w)};
        f32x4 y0, y1;
#pragma unroll
        for (int e = 0; e < 4; ++e) { y0[e] = b0[e] * cv0[e] * g0[e] * sigmoidf_(g0[e]); y1[e] = b1[e] * cv1[e] * g1[e] * sigmoidf_(g1[e]); }
        v4u o; o.x = pk2(y0[0], y0[1]); o.y = pk2(y0[2], y0[3]); o.z = pk2(y1[0], y1[1]); o.w = pk2(y1[2], y1[3]);
        *(v4u*)(ycat + (size_t)(tstart + r) * MIXW + chb) = o;
        cm2[0] = cm1[0]; cm2[1] = cm1[1]; cm1[0] = c0; cm1[1] = c1; }
}

constexpr int SC_XB = 0, SC_XBS = 272, SC_XF = 64 * 272, SC_XFS = 528, SC_GT = SC_XF + 64 * 528, SC_GTS = 272;
template <int PASS>
__device__ __forceinline__ void scan_unit(Frame& F, int c, int h) {
    LAS unsigned char* L = F.lds;
    const bf16* proj = (const bf16*)(F.ws + WS_PROJ);
    const int tid = F.tid, lane = F.lane, w = F.wave, fr = lane & 15, fq = lane >> 4, t0 = c * 64;
    const int chl = w * 16 + fr, ch = h * HD + chl;
    float hin = 0.f;
    if (PASS == 1) { const f32x2* ag = (const f32x2*)(F.ws + WS_AGG) + ch;
#pragma unroll 8
        for (int cc = 0; cc < c; ++cc) { const f32x2 v = ag[(size_t)cc * DM]; hin = v[0] * hin + v[1]; } }
    {
        const int cg8 = tid & 15, chb = h * HD + cg8 * 8;
        f32x4 wk[4][2], bb[2];
#pragma unroll
        for (int k = 0; k < 4; ++k) { wk[k][0] = *(const f32x4*)(F.cbw + k * DM + chb); wk[k][1] = *(const f32x4*)(F.cbw + k * DM + chb + 4); }
        bb[0] = *(const f32x4*)(F.cbb + chb); bb[1] = *(const f32x4*)(F.cbb + chb + 4);
#pragma unroll
        for (int it = 0; it < 2; ++it) { const int r = (tid >> 4) + it * 32, t = t0 + r;
            f32x4 a0 = bb[0], a1 = bb[1];
#pragma unroll
            for (int k = 0; k < 4; ++k) { const int tt = t - 3 + k;
                if (tt >= 0) { const v4u v = *(const v4u*)(proj + (size_t)tt * INC + 4 * DM + chb);
                    a0 += wk[k][0] * (f32x4){bflo(v.x), bfhi(v.x), bflo(v.y), bfhi(v.y)}; a1 += wk[k][1] * (f32x4){bflo(v.z), bfhi(v.z), bflo(v.w), bfhi(v.w)}; } }
            v4u o; o.x = pk2(a0[0], a0[1]); o.y = pk2(a0[2], a0[3]); o.z = pk2(a1[0], a1[1]); o.w = pk2(a1[2], a1[3]);
            *(LAS v4u*)(L + SC_XB + r * SC_XBS + cg8 * 16) = o;
            *(LAS f32x4*)(L + SC_XF + r * SC_XFS + cg8 * 32) = a0; *(LAS f32x4*)(L + SC_XF + r * SC_XFS + cg8 * 32 + 16) = a1;
            if (PASS == 1) { const v4u gv = *(const v4u*)(proj + (size_t)t * INC + 5 * DM + chb); *(LAS v4u*)(L + SC_GT + r * SC_GTS + cg8 * 16) = gv; } }
    }
    const bf16* wg = (const bf16*)(F.ws + WS_WG) + ((size_t)(h * 256 + chl)) * HD + fq * 8;
    bf16x8 br[4], bi[4];
#pragma unroll
    for (int ks = 0; ks < 4; ++ks) { br[ks] = *(const bf16x8*)(wg + ks * 32); bi[ks] = *(const bf16x8*)(wg + HD * HD + ks * 32); }
    const float brg = F.b_r[ch], big = F.b_i[ch], c8 = -8.0f * log1pf(expf(-F.lam[ch]));
    __syncthreads();
    f32x4 ar[4], ai[4];
#pragma unroll
    for (int rb = 0; rb < 4; ++rb) { ar[rb] = (f32x4){0.f, 0.f, 0.f, 0.f}; ai[rb] = ar[rb];
#pragma unroll
        for (int ks = 0; ks < 4; ++ks) { const bf16x8 a = *(const LAS bf16x8*)(L + SC_XB + (rb * 16 + fr) * SC_XBS + (ks * 32 + fq * 8) * 2);
            ar[rb] = __builtin_amdgcn_mfma_f32_16x16x32_bf16(a, br[ks], ar[rb], 0, 0, 0); ai[rb] = __builtin_amdgcn_mfma_f32_16x16x32_bf16(a, bi[ks], ai[rb], 0, 0, 0); } }
    f32x4 Pv[4], Hv[4];
#pragma unroll
    for (int rb = 0; rb < 4; ++rb) { float Pc = 1.f, Hc = 0.f;
#pragma unroll
        for (int idx = 0; idx < 4; ++idx) { const int tl = rb * 16 + fq * 4 + idx;
            const float xc = *(const LAS float*)(L + SC_XF + tl * SC_XFS + chl * 4);
            const float r = sigmoidf_(ar[rb][idx] + brg), ig = sigmoidf_(ai[rb][idx] + big);
            const float la = c8 * r, a = expf(la); float mult = sqrtf(-expm1f(2.0f * la)); if (t0 + tl == 0) mult = 1.0f;
            const float uu = mult * ig * xc;
            Hc = a * Hc + uu; Pc *= a; Pv[rb][idx] = Pc; Hv[rb][idx] = Hc; } }
    float hcar = hin, Pchunk = 1.f;
#pragma unroll
    for (int rb = 0; rb < 4; ++rb) {
        float Pt = Pv[rb][3], Ht = Hv[rb][3];
        float Pp = __shfl_up(Pt, 16), Hp = __shfl_up(Ht, 16); if (fq >= 1) { Ht = Pt * Hp + Ht; Pt = Pt * Pp; }
        Pp = __shfl_up(Pt, 32); Hp = __shfl_up(Ht, 32); if (fq >= 2) { Ht = Pt * Hp + Ht; Pt = Pt * Pp; }
        float Pe = __shfl_up(Pt, 16), He = __shfl_up(Ht, 16); if (fq == 0) { Pe = 1.f; He = 0.f; }
        const float Ptot = __shfl(Pt, fr + 48), Htot = __shfl(Ht, fr + 48);
        if (PASS == 1) { const float hent = Pe * hcar + He;
#pragma unroll
            for (int idx = 0; idx < 4; ++idx) { const int tl = rb * 16 + fq * 4 + idx; const float hv = Pv[rb][idx] * hent + Hv[rb][idx];
                LAS unsigned short* gp = (LAS unsigned short*)(L + SC_GT + tl * SC_GTS + chl * 2);
                const float g = __builtin_bit_cast(float, (unsigned)(*gp) << 16); const float y = hv * g * sigmoidf_(g);
                *gp = (unsigned short)(pk2(y, 0.f) & 0xffffu); } }
        hcar = Ptot * hcar + Htot; Pchunk *= Ptot;
    }
    if (PASS == 0) { if (fq == 0) *((f32x2*)(F.ws + WS_AGG) + (size_t)c * DM + ch) = (f32x2){Pchunk, hcar}; __syncthreads(); }
    else { __syncthreads();
        bf16* ycat = (bf16*)(F.ws + WS_YCAT);
#pragma unroll
        for (int it = 0; it < 2; ++it) { const int r = (tid >> 4) + it * 32, cg8 = tid & 15;
            *(v4u*)(ycat + (size_t)(t0 + r) * MIXW + DM + h * HD + cg8 * 8) = *(const LAS v4u*)(L + SC_GT + r * SC_GTS + cg8 * 16); }
        __syncthreads(); }
}

__device__ __forceinline__ void final_norm_row(float* row, const float* g, int lane) {
    f32x4* xr = (f32x4*)row + lane; const f32x4* gr = (const f32x4*)g + lane;
    f32x4 v[8]; float s = 0.f;
#pragma unroll
    for (int j = 0; j < 8; ++j) { v[j] = xr[64 * j]; s += (v[j][0] * v[j][0] + v[j][1] * v[j][1]) + (v[j][2] * v[j][2] + v[j][3] * v[j][3]); }
    const float rstd = 1.0f / sqrtf(wave_sum(s) * (1.0f / DM) + RMS_EPS);
#pragma unroll
    for (int j = 0; j < 8; ++j) xr[64 * j] = v[j] * rstd * gr[64 * j];
}

__global__ void __launch_bounds__(NWAVES * 64, 2) hymba_fwd(Args args) {
    extern __shared__ __attribute__((aligned(16))) unsigned char lds[];
    cg::grid_group grid = cg::this_grid();
    Frame F;
    F.lds = (LAS unsigned char*)lds;
    F.tid = threadIdx.x; F.lane = F.tid & 63; F.wave = __builtin_amdgcn_readfirstlane(F.tid >> 6);
    F.G = gridDim.x; { const int bx = blockIdx.x; F.vcu = (F.G % 8 == 0) ? (bx % 8) * (F.G / 8) + bx / 8 : bx; }
    F.x = args.in[0]; F.mem = args.in[1]; F.g_mix = args.in[2]; F.w_in = args.in[3]; F.caw = args.in[4]; F.cab = args.in[5]; F.cbw = args.in[6]; F.cbb = args.in[7];
    F.w_r = args.in[8]; F.b_r = args.in[9]; F.w_i = args.in[10]; F.b_i = args.in[11]; F.lam = args.in[12]; F.w_out = args.in[13]; F.g_x = args.in[14]; F.g_mem = args.in[15];
    F.w_q = args.in[16]; F.w_kv = args.in[17]; F.w_o = args.in[18]; F.g_f = args.in[19]; F.out = args.out; F.ws = args.ws;
    unsigned char* ws = args.ws;
    const int lo = args.ph_lo, hi = args.ph_hi;
    volatile LAS unsigned* MISC = (volatile LAS unsigned*)(F.lds + RING_BYTES + 64);
    if (F.tid < 2) MISC[F.tid] = 0u;
    __syncthreads();
    XcdBarrier bar = xcd_barrier_post((unsigned*)(ws + WS_BAR), MISC);
    if (lo < 0) grid.sync();
#define IN(k) (lo <= (k) && (k) < hi)
#define SEAM(k) do { if (IN(k) && IN((k) + 1)) xcd_barrier(bar); } while (0)

    if (IN(0)) { p0_prologue(F); }
    SEAM(0);
    if (IN(1)) {
        { pg8::Gemm g{DM, DM, DM}; pg8::SchedStd S; S.init(ws + WS_XN, DM, ws + WS_WIN, DM, SEQ, INC, F.G, (int)blockIdx.x);
          pg8::EpiProj E{(pg8::bf16_t*)(ws + WS_PROJ), INC};
          pg8::gemm_phase<pg8::EpiProj, pg8::SchedStd, true>(F.lds, g, S, E); }
        { pg8::Gemm g{DM, DM, DM}; pg8::SchedKV S{(const char*)(ws + WS_MN), (const char*)(ws + WS_WKV), F.G, (int)blockIdx.x};
          pg8::EpiKV E{(pg8::bf16_t*)(ws + WS_KB), (pg8::bf16_t*)(ws + WS_VT)};
          pg8::gemm_phase<pg8::EpiKV, pg8::SchedKV, true>(F.lds, g, S, E); }
    }
    SEAM(1);
    if (IN(2)) {
        for (int u = F.vcu; u < SEQ / 32; u += F.G) conva_unit(F, u);
        for (int u = F.vcu; u < 128 * NHB; u += F.G) scan_unit<0>(F, u >> 4, u & 15);
    }
    SEAM(2);
    if (IN(3)) {
        for (int u = F.vcu; u < 128 * NHB; u += F.G) scan_unit<1>(F, u >> 4, u & 15);
    }
    SEAM(3);
    if (IN(4)) {
        pg8::Gemm g{MIXW, MIXW, MIXW}; pg8::SchedStd S; S.init(ws + WS_YCAT, MIXW, ws + WS_WOUT, MIXW, SEQ, DM, F.G, (int)blockIdx.x);
        pg8::EpiRes1 E{F.x, F.out, (pg8::bf16_t*)(ws + WS_H1B), (float*)(ws + WS_ROWSS)};
        pg8::gemm_phase<pg8::EpiRes1, pg8::SchedStd, true>(F.lds, g, S, E);
    }
    SEAM(4);
    if (IN(5)) {
        pg8::Gemm g{DM, DM, DM}; pg8::SchedStd S; S.init(ws + WS_H1B, DM, ws + WS_WQ, DM, SEQ, DM, F.G, (int)blockIdx.x);
        pg8::EpiQ E{(pg8::bf16_t*)(ws + WS_Q), (const float*)(ws + WS_ROWSS), 0.04419417382415922f * 1.4426950408889634f};
        pg8::gemm_phase<pg8::EpiQ, pg8::SchedStd, true>(F.lds, g, S, E);
    }
    SEAM(5);
    if (IN(6)) {
        pg8::Gemm g{DM, DM, XHD}; pg8::SchedS S{(const char*)(ws + WS_Q), (const char*)(ws + WS_KB), F.G, (int)blockIdx.x};
        pg8::EpiSoftmax E{(pg8::bf16_t*)(ws + WS_P), (float*)(ws + WS_LP)};
        pg8::gemm_phase<pg8::EpiSoftmax, pg8::SchedS, false>(F.lds, g, S, E);
    }
    SEAM(6);
    if (IN(7)) {
        pg8::Gemm g{1024, 256, 256}; pg8::SchedO S{(const char*)(ws + WS_P), (const char*)(ws + WS_VT), F.G, (int)blockIdx.x};
        pg8::EpiO E{(pg8::bf16_t*)(ws + WS_O), (const float*)(ws + WS_LP)};
        pg8::gemm_phase<pg8::EpiO, pg8::SchedO, true>(F.lds, g, S, E);
    }
    SEAM(7);
    if (IN(8)) {
        pg8::Gemm g{DM, DM, DM}; pg8::SchedStd S; S.init(ws + WS_O, DM, ws + WS_WO, DM, SEQ, DM, F.G, (int)blockIdx.x);
        pg8::EpiRes2 E{F.out};
        pg8::gemm_phase<pg8::EpiRes2, pg8::SchedStd, true>(F.lds, g, S, E);
    }
    SEAM(8);
    if (IN(9)) {
        const int gw = F.vcu * NWAVES + F.wave, NGW = F.G * NWAVES;
        for (int m = gw; m < SEQ; m += NGW) final_norm_row(F.out + (size_t)m * DM, F.g_f, F.lane);
    }
#undef IN
#undef SEAM
}

extern "C" void kernel_launch(void* const* d_in, const int* in_sizes, int n_in, void* d_out, int out_size, void* d_ws, size_t ws_size, hipStream_t stream) {
    static int grid = 0;
    if (grid == 0) {
        if (n_in != 20 || out_size != SEQ * DM || ws_size < WS_END) { fprintf(stderr, "kernel_launch: unexpected shapes (n_in %d out %d ws %zu)\n", n_in, out_size, ws_size); grid = -1; return; }
        int dev = 0, cus = 0, per_cu = 0;
        if (hipGetDevice(&dev) != hipSuccess || hipDeviceGetAttribute(&cus, hipDeviceAttributeMultiprocessorCount, dev) != hipSuccess) { grid = -1; return; }
        if (hipFuncSetAttribute((const void*)hymba_fwd, hipFuncAttributeMaxDynamicSharedMemorySize, LDS_BYTES) != hipSuccess) { fprintf(stderr, "kernel_launch: hipFuncSetAttribute failed\n"); grid = -1; return; }
        if (hipOccupancyMaxActiveBlocksPerMultiprocessor(&per_cu, (const void*)hymba_fwd, NWAVES * 64, LDS_BYTES) != hipSuccess || per_cu < 1) { fprintf(stderr, "kernel_launch: occupancy query says %d\n", per_cu); }
        (void)hipGetLastError();
        grid = cus;
    }
    if (grid < 0) return;
    if (hipMemsetAsync((char*)d_ws, 0, CTL_ZERO_BYTES, stream) != hipSuccess) { fprintf(stderr, "kernel_launch: memset failed\n"); return; }
    Args a{};
    for (int i = 0; i < 20; ++i) a.in[i] = (const float*)d_in[i];
    a.out = (float*)d_out; a.ws = (unsigned char*)d_ws;
#if MK_N_LAUNCHES == 1
    a.ph_lo = 0; a.ph_hi = N_PHASES;
    void* kargs[] = {&a};
    hipError_t e = hipLaunchCooperativeKernel((const void*)hymba_fwd, dim3(grid), dim3(NWAVES * 64), kargs, LDS_BYTES, stream);
    if (e != hipSuccess) fprintf(stderr, "kernel_launch: cooperative launch failed: %s\n", hipGetErrorString(e));
#else
    for (int p = 0; p < N_PHASES; ++p) {
        a.ph_lo = p; a.ph_hi = p + 1;
        void* kargs[] = {&a};
        hipError_t e = hipLaunchCooperativeKernel((const void*)hymba_fwd, dim3(grid), dim3(NWAVES * 64), kargs, LDS_BYTES, stream);
        if (e != hipSuccess) { fprintf(stderr, "kernel_launch: launch %d failed: %s\n", p, hipGetErrorString(e)); break; }
    }
#endif
}
```

```cpp
#include <hip/hip_runtime.h>
#include <hip/hip_cooperative_groups.h>
#include <cstdio>
#include <cstdint>
namespace cg = cooperative_groups;

#define PHASE_PLAN {{0, 10}}

namespace pg8 {
#define PG8_LAS __attribute__((address_space(3)))
typedef unsigned short bf16_t;
typedef short bf16x8 __attribute__((ext_vector_type(8)));
typedef float f32x4 __attribute__((ext_vector_type(4)));
typedef unsigned u32x4 __attribute__((ext_vector_type(4)));
constexpr int BM = 256, BK = 64, HALF = 128, HTB = HALF * BK * 2, STAGE_BYTES = 8 * HTB, NXCD = 8, WGM = 8;

__host__ __device__ __forceinline__ int lds_byte(int r, int c) { const int st = (r >> 4) * 2 + (c >> 5), rr = r & 15, cc = c & 31, ob = rr * 64 + cc * 2; return st * 1024 + (ob ^ (((ob >> 9) & 1) << 5)); }
__host__ __device__ __forceinline__ void stage_rc(int b, int& R, int& C) { const int st = b / 1024, sb = b % 1024, swz = sb ^ (((sb >> 9) & 1) << 5); R = (st >> 1) * 16 + swz / 64; C = (st & 1) * 32 + (swz % 64) / 2; }
__host__ __device__ __forceinline__ int perm32(int rho) { const int n = rho >> 4, i = rho & 15; return 8 * (i >> 2) + 4 * n + (i & 3); }

struct Unit { int pm, pn; };
struct Gemm { int lda, ldb, K; };

__device__ __forceinline__ unsigned cvt_pk_bf16(float lo, float hi) { unsigned r; asm volatile("v_cvt_pk_bf16_f32 %0, %1, %2" : "=v"(r) : "v"(lo), "v"(hi)); return r; }

struct SchedStd {
    const char* A; const char* B; size_t strideA, strideB;
    int nM, nN, nwg, G, c;
    __device__ __forceinline__ void init(const void* A_, int lda, const void* B_, int ldb, int M, int N, int G_, int c_) {
        A = (const char*)A_; B = (const char*)B_; strideA = (size_t)BM * lda * 2; strideB = (size_t)BM * ldb * 2; nM = M / BM; nN = N / BM; nwg = nM * nN; G = G_; c = c_; }
    __device__ __forceinline__ bool next(int i, Unit& u) const {
        const long L = (long)i * G + c; if (L >= nwg) return false;
        int wgid = (int)L; { const int q = nwg / NXCD, r = nwg % NXCD, xcd = wgid % NXCD, off = wgid / NXCD; wgid = (xcd < r ? xcd * (q + 1) : r * (q + 1) + (xcd - r) * q) + off; }
        const int nig = WGM * nN, gid = wgid / nig, fm = gid * WGM, gsz = (nM - fm) < WGM ? (nM - fm) : WGM;
        u.pm = fm + ((wgid % nig) % gsz); u.pn = (wgid % nig) / gsz; return true;
    }
    __device__ __forceinline__ const char* a_base(const Unit& u) const { return A + (size_t)u.pm * strideA; }
    __device__ __forceinline__ const char* b_base(const Unit& u) const { return B + (size_t)u.pn * strideB; }
};

template <class Epi, class Sched, bool ALIGN_EPI>
__device__ __forceinline__ void gemm_phase(PG8_LAS unsigned char* lds, const Gemm g, const Sched& S, const Epi& E) {
    const int tid = threadIdx.x, wid = __builtin_amdgcn_readfirstlane(tid >> 6), lane = tid & 63, wr = wid >> 2, wc = wid & 3, fr = lane & 15, fq = lane >> 4;
    const int K = g.K, nt = K / BK;
    unsigned voffA[2], voffB[2];
#pragma unroll
    for (int i = 0; i < 2; ++i) { int R, C; stage_rc(tid * 16 + i * 8192, R, C); const int Rb = Epi::PERM ? ((R & ~31) + perm32(R & 31)) : R;
        voffA[i] = (unsigned)(R * g.lda + C) * 2u; voffB[i] = (unsigned)(Rb * g.ldb + C) * 2u; }
    const size_t kstep = (size_t)(BK * 2);
    const size_t hA = (size_t)HALF * g.lda * 2, hB = (size_t)HALF * g.ldb * 2;
    const unsigned ldsw = (unsigned)wid * 1024u;
    const int aoff = lds_byte(wr * 64 + fr, fq * 8), boff = lds_byte(wc * 32 + fr, fq * 8);
#define PG8_SA(b, h) (((b) * 2 + (h)) * HTB)
#define PG8_SB(b, h) ((4 + (b) * 2 + (h)) * HTB)
#define PG8_STAGE(bufoff, gbase, voff) do { _Pragma("unroll") for (int _i = 0; _i < 2; ++_i) \
        __builtin_amdgcn_global_load_lds((const unsigned*)((const char*)(gbase) + (voff)[_i]), (PG8_LAS unsigned*)(lds + (bufoff) + ldsw + _i * 8192), 16, 0, 0); } while (0)
#define PG8_LDA(dst, b, h) do { _Pragma("unroll") for (int m = 0; m < 4; ++m) _Pragma("unroll") for (int k = 0; k < 2; ++k) dst[m][k] = *(const PG8_LAS bf16x8*)(lds + PG8_SA(b, h) + aoff + m * 2048 + k * 1024); } while (0)
#define PG8_LDB(dst, b, h) do { _Pragma("unroll") for (int n = 0; n < 2; ++n) _Pragma("unroll") for (int k = 0; k < 2; ++k) dst[n][k] = *(const PG8_LAS bf16x8*)(lds + PG8_SB(b, h) + boff + n * 2048 + k * 1024); } while (0)
#define PG8_MMA(ai, bj, At, Bt) do { __builtin_amdgcn_s_setprio(1); _Pragma("unroll") for (int m = 0; m < 4; ++m) _Pragma("unroll") for (int n = 0; n < 2; ++n) _Pragma("unroll") for (int k = 0; k < 2; ++k) \
        acc[ai][bj][m][n] = __builtin_amdgcn_mfma_f32_16x16x32_bf16(Bt[n][k], At[m][k], acc[ai][bj][m][n], 0, 0, 0); __builtin_amdgcn_s_setprio(0); } while (0)
#define PG8_WAIT_V(n) asm volatile("s_waitcnt vmcnt(" #n ")" ::: "memory")
#define PG8_WAIT_L(n) asm volatile("s_waitcnt lgkmcnt(" #n ")" ::: "memory")
#define PG8_BAR __builtin_amdgcn_s_barrier()
#define PG8_SCHED __builtin_amdgcn_sched_barrier(0)
    Unit cur, nxt; int ui = 0;
    if (!S.next(0, cur)) return;
    f32x4 acc[2][2][4][2];
#pragma unroll
    for (int a = 0; a < 2; ++a)
#pragma unroll
        for (int b = 0; b < 2; ++b)
#pragma unroll
            for (int m = 0; m < 4; ++m)
#pragma unroll
                for (int n = 0; n < 2; ++n) acc[a][b][m][n] = (f32x4){0.f, 0.f, 0.f, 0.f};
    bf16x8 At[4][2], B0[2][2], B1[2][2];
    const char* cA = S.a_base(cur); const char* cB = S.b_base(cur);
    PG8_STAGE(PG8_SB(0, 0), cB, voffB); PG8_STAGE(PG8_SB(0, 1), cB + hB, voffB); PG8_STAGE(PG8_SA(0, 0), cA, voffA); PG8_STAGE(PG8_SA(0, 1), cA + hA, voffA);
    if (wr == 1) PG8_BAR;
    PG8_WAIT_V(2); PG8_BAR;
    PG8_STAGE(PG8_SB(1, 0), cB + kstep, voffB); PG8_STAGE(PG8_SA(1, 0), cA + kstep, voffA); PG8_STAGE(PG8_SB(1, 1), cB + hB + kstep, voffB);
    PG8_WAIT_V(6); PG8_BAR;
    for (;;) {
        const bool has_next = S.next(ui + 1, nxt);
        const char* nA = has_next ? S.a_base(nxt) : cA; const char* nB = has_next ? S.b_base(nxt) : cB;
        for (int t = 0; t < nt; t += 2) {
            const bool last = (t == nt - 2);
            const char* a1 = cA + (size_t)(t + 1) * kstep;
            const char* a2 = last ? nA : cA + (size_t)(t + 2) * kstep; const char* b2 = last ? nB : cB + (size_t)(t + 2) * kstep;
            const char* a3 = a2 + kstep; const char* b3 = b2 + kstep;
            PG8_LDB(B0, 0, 0); PG8_LDB(B1, 0, 1); PG8_SCHED; PG8_LDA(At, 0, 0); PG8_STAGE(PG8_SA(1, 1), a1 + hA, voffA);
            PG8_WAIT_V(8); PG8_WAIT_L(0); PG8_BAR; PG8_MMA(0, 0, At, B0); PG8_MMA(0, 1, At, B1); PG8_BAR; PG8_SCHED;
            PG8_LDA(At, 0, 1); PG8_STAGE(PG8_SB(0, 0), b2, voffB); PG8_STAGE(PG8_SB(0, 1), b2 + hB, voffB); PG8_STAGE(PG8_SA(0, 0), a2, voffA);
            PG8_WAIT_V(8); PG8_WAIT_L(0); PG8_BAR; PG8_MMA(1, 0, At, B0); PG8_MMA(1, 1, At, B1); PG8_BAR; PG8_SCHED;
            PG8_LDB(B0, 1, 0); PG8_LDB(B1, 1, 1); PG8_SCHED; PG8_LDA(At, 1, 0); PG8_STAGE(PG8_SA(0, 1), a2 + hA, voffA);
            PG8_WAIT_V(8); PG8_WAIT_L(0); PG8_BAR; PG8_MMA(0, 0, At, B0); PG8_MMA(0, 1, At, B1); PG8_BAR; PG8_SCHED;
            PG8_LDA(At, 1, 1); PG8_STAGE(PG8_SB(1, 0), b3, voffB); PG8_STAGE(PG8_SB(1, 1), b3 + hB, voffB); PG8_STAGE(PG8_SA(1, 0), a3, voffA);
            PG8_WAIT_V(8); PG8_WAIT_L(0); PG8_BAR; PG8_MMA(1, 0, At, B0); PG8_MMA(1, 1, At, B1); PG8_BAR; PG8_SCHED;
        }
        if constexpr (ALIGN_EPI) { if (wr == 0) PG8_BAR; }
        if constexpr (!Epi::AFTER_DRAIN) { E(acc, cur, wr, wc, fr, fq); }
        if (!has_next) break;
#pragma unroll
        for (int a = 0; a < 2; ++a)
#pragma unroll
            for (int b = 0; b < 2; ++b)
#pragma unroll
                for (int m = 0; m < 4; ++m)
#pragma unroll
                    for (int n = 0; n < 2; ++n) acc[a][b][m][n] = (f32x4){0.f, 0.f, 0.f, 0.f};
        cur = nxt; cA = nA; cB = nB; ++ui;
        if constexpr (ALIGN_EPI) { if (wr == 1) PG8_BAR; }
    }
    PG8_WAIT_V(0);
    if constexpr (!ALIGN_EPI) { if (wr == 0) PG8_BAR; }
    PG8_BAR;
    if constexpr (Epi::AFTER_DRAIN) { E.fused(acc, cur, wr, wc, fr, fq, lds, wid, lane); }
#undef PG8_SA
#undef PG8_SB
#undef PG8_STAGE
#undef PG8_LDA
#undef PG8_LDB
#undef PG8_MMA
#undef PG8_WAIT_V
#undef PG8_WAIT_L
#undef PG8_BAR
#undef PG8_SCHED
}
}

constexpr int NWAVES = 8;
constexpr int SEQ = 8192, DM = 2048, NMEM = 256, INC = 12288, MIXW = 4096, NHB = 16, HD = 128, XH = 4, XHD = 512;
constexpr float RMS_EPS = 1e-6f;
constexpr int N_PHASES = 10;

constexpr size_t MiB = 1u << 20;
constexpr size_t WS_ROWSS = 0;
constexpr size_t WS_BAR = 65536;
constexpr size_t CTL_ZERO_BYTES = 131072;
constexpr size_t WS_WG = 1 * MiB;
constexpr size_t WS_MN = 2 * MiB;
constexpr size_t WS_KB = 3 * MiB;
constexpr size_t WS_VT = 4 * MiB;
constexpr size_t WS_AGG = 5 * MiB;
constexpr size_t WS_LP = 7 * MiB;
constexpr size_t WS_WOUT = 8 * MiB;
constexpr size_t WS_WQ = 24 * MiB;
constexpr size_t WS_WO = 32 * MiB;
constexpr size_t WS_WIN = 40 * MiB;
constexpr size_t WS_WKV = 88 * MiB;
constexpr size_t WS_XN = 104 * MiB;
constexpr size_t WS_YCAT = 40 * MiB;
constexpr size_t WS_PROJ = 136 * MiB;
constexpr size_t WS_H1B = 136 * MiB;
constexpr size_t WS_Q = 168 * MiB;
constexpr size_t WS_P = 200 * MiB;
constexpr size_t WS_O = 216 * MiB;
constexpr size_t WS_END = 328 * MiB;

constexpr int RING_BYTES = 131072;
constexpr int LDS_BYTES = 147456;

#define GAS __attribute__((address_space(1)))
#define LAS __attribute__((address_space(3)))
typedef unsigned short bf16;
typedef unsigned v4u __attribute__((ext_vector_type(4)));
typedef unsigned v2u __attribute__((ext_vector_type(2)));
typedef float f32x4 __attribute__((ext_vector_type(4)));
typedef float f32x2 __attribute__((ext_vector_type(2)));
typedef short bf16x8 __attribute__((ext_vector_type(8)));
#define LDS_WAIT() asm volatile("s_waitcnt lgkmcnt(0)" ::: "memory")

__device__ __forceinline__ unsigned pk2(float lo, float hi) { return pg8::cvt_pk_bf16(lo, hi); }
__device__ __forceinline__ float bflo(unsigned v) { return __builtin_bit_cast(float, v << 16); }
__device__ __forceinline__ float bfhi(unsigned v) { return __builtin_bit_cast(float, v & 0xffff0000u); }
__device__ __forceinline__ float wave_sum(float v) {
#pragma unroll
    for (int o = 1; o < 64; o <<= 1) v += __shfl_xor(v, o);
    return v;
}
__device__ __forceinline__ float sigmoidf_(float x) { return __builtin_amdgcn_rcpf(1.0f + __builtin_amdgcn_exp2f(-1.4426950408889634f * x)); }


#define XB_TMO      128
#define XB_XCNT(j)  (256  + 64 * (j))
#define XB_XSUB(j)  (1280 + 64 * (j))
#define XB_XGEN(j)  (2304 + 64 * (j))
#define XB_TOP      3328
#define XB_TOPGEN   3392
#define XCD_BAR_WORDS 3456
#define XB_SPIN_CAP (1u << 18)
__device__ __forceinline__ unsigned xb_ld(unsigned* p)              { return __hip_atomic_load(p, __ATOMIC_RELAXED, __HIP_MEMORY_SCOPE_AGENT); }
__device__ __forceinline__ unsigned xb_add(unsigned* p, unsigned v) { return __hip_atomic_fetch_add(p, v, __ATOMIC_RELAXED, __HIP_MEMORY_SCOPE_AGENT); }
__device__ __forceinline__ unsigned xb_xcc_id() { return (unsigned)__builtin_amdgcn_s_getreg((3 << 11) | 20) & 0xFu; }
#define XB_SPIN(cond, bar) do { unsigned _sp = 0; while (cond) { __builtin_amdgcn_s_sleep(1); \
    if ((++_sp & 255u) == 0u) { if (xb_ld(&(bar)[XB_TMO])) break; if (_sp > XB_SPIN_CAP) { atomicAdd(&(bar)[XB_TMO], 1u); break; } } } } while (0)
struct XcdBarrier { unsigned* bar; unsigned x; volatile LAS unsigned* st; };
__device__ __forceinline__ XcdBarrier xcd_barrier_post(unsigned* bar, volatile LAS unsigned* st) {
    XcdBarrier b; b.bar = bar; b.x = xb_xcc_id(); b.st = st;
    if (threadIdx.x == 0) (void)xb_add(&bar[XB_XCNT(b.x)], 1u);
    return b;
}
__device__ __forceinline__ void xcd_barrier_complete(unsigned* bar, unsigned x, unsigned& nloc, unsigned& nx) {
    const unsigned G = gridDim.x * gridDim.y * gridDim.z;
    unsigned sum, cnt, mine, sp = 0u;
    for (;;) {
        sum = 0u; cnt = 0u; mine = 0u;
#pragma unroll
        for (unsigned j = 0; j < 16; ++j) { const unsigned c = xb_ld(&bar[XB_XCNT(j)]); sum += c; cnt += (c > 0u) ? 1u : 0u; mine = (j == x) ? c : mine; }
        if (sum == G) break;
        __builtin_amdgcn_s_sleep(1);
        if ((++sp & 255u) == 0u) { if (xb_ld(&bar[XB_TMO])) break; if (sp > XB_SPIN_CAP) { atomicAdd(&bar[XB_TMO], 1u); break; } }
    }
    nloc = mine > 0u ? mine : 1u; nx = cnt > 0u ? cnt : 1u;
}
__device__ __forceinline__ void xcd_barrier(const XcdBarrier& b) {
    asm volatile("s_waitcnt vmcnt(0)" ::: "memory");
    __syncthreads();
    if (threadIdx.x == 0) {
        unsigned* bar = b.bar;
        __builtin_amdgcn_s_waitcnt(0);
        unsigned nloc = b.st[0], nx = b.st[1];
        if (nloc == 0u) { xcd_barrier_complete(bar, b.x, nloc, nx); b.st[0] = nloc; b.st[1] = nx; }
        const unsigned old = xb_add(&bar[XB_XSUB(b.x)], 1u);
        const unsigned gen = old / nloc;
        if (old + 1u == (gen + 1u) * nloc) {
            __builtin_amdgcn_fence(__ATOMIC_RELEASE, "agent");
            asm volatile("s_waitcnt vmcnt(0)" ::: "memory");
            const unsigned og = xb_add(&bar[XB_TOP], 1u);
            const unsigned tg = og / nx;
            if (og + 1u == (tg + 1u) * nx) xb_add(&bar[XB_TOPGEN], 1u);
            else XB_SPIN(xb_ld(&bar[XB_TOPGEN]) == tg, bar);
            __builtin_amdgcn_fence(__ATOMIC_ACQUIRE, "agent");
            xb_add(&bar[XB_XGEN(b.x)], 1u);
            asm volatile("s_waitcnt vmcnt(0)" ::: "memory");
        } else {
            XB_SPIN(xb_ld(&bar[XB_XGEN(b.x)]) == gen, bar);
            __builtin_amdgcn_fence(__ATOMIC_ACQUIRE, "agent");
            asm volatile("s_waitcnt vmcnt(0)" ::: "memory");
        }
    }
    __syncthreads();
}

struct Args {
    const float* in[20]; float* out; unsigned char* ws; int ph_lo, ph_hi, li, pad;
};

struct Frame {
    LAS unsigned char* lds;
    int tid, lane, wave, vcu, G;
    const float *x, *mem, *g_mix, *w_in, *caw, *cab, *cbw, *cbb, *w_r, *b_r, *w_i, *b_i, *lam, *w_out, *g_x, *g_mem, *w_q, *w_kv, *w_o, *g_f;
    float* out; unsigned char* ws;
};

namespace pg8 {
__device__ __forceinline__ void store_tile_bf16(const f32x4 (&acc)[2][2][4][2], bf16_t* tile, int ldc, int wr, int wc, int fr, int fq) {
#pragma unroll
    for (int ai = 0; ai < 2; ++ai)
#pragma unroll
        for (int m = 0; m < 4; ++m) { bf16_t* rowp = tile + (size_t)(ai * HALF + wr * 64 + m * 16 + fr) * ldc + wc * 32 + 8 * fq;
#pragma unroll
            for (int bj = 0; bj < 2; ++bj) { const f32x4 v0 = acc[ai][bj][m][0], v1 = acc[ai][bj][m][1];
                u32x4 w; w.x = cvt_pk_bf16(v0[0], v0[1]); w.y = cvt_pk_bf16(v0[2], v0[3]); w.z = cvt_pk_bf16(v1[0], v1[1]); w.w = cvt_pk_bf16(v1[2], v1[3]);
                *(u32x4*)(rowp + bj * HALF) = w; } }
}
struct EpiProj {
    static constexpr bool PERM = true, AFTER_DRAIN = false;
    bf16_t* O; int ldc;
    __device__ __forceinline__ void operator()(const f32x4 (&acc)[2][2][4][2], const Unit& u, int wr, int wc, int fr, int fq) const {
        store_tile_bf16(acc, O + (size_t)u.pm * BM * ldc + (size_t)u.pn * BM, ldc, wr, wc, fr, fq); }
};
struct SchedKV {
    const char* mn; const char* wkv; int G, c;
    __device__ __forceinline__ bool next(int i, Unit& u) const { const int L = i * G + c; if (L >= 16) return false; u.pm = L; u.pn = 0; return true; }
    __device__ __forceinline__ const char* a_base(const Unit& u) const { return u.pm < 8 ? mn : wkv + (size_t)(2048 + (u.pm - 8) * 256) * 2048 * 2; }
    __device__ __forceinline__ const char* b_base(const Unit& u) const { return u.pm < 8 ? wkv + (size_t)(u.pm * 256) * 2048 * 2 : mn; }
};
struct EpiKV {
    static constexpr bool PERM = true, AFTER_DRAIN = false;
    bf16_t* Kb; bf16_t* Vt;
    __device__ __forceinline__ void operator()(const f32x4 (&acc)[2][2][4][2], const Unit& u, int wr, int wc, int fr, int fq) const {
        if (u.pm < 8) store_tile_bf16(acc, Kb + (size_t)u.pm * BM, 2048, wr, wc, fr, fq);
        else store_tile_bf16(acc, Vt + (size_t)(u.pm - 8) * BM * 256, 256, wr, wc, fr, fq); }
};
struct EpiRes1 {
    static constexpr bool PERM = true, AFTER_DRAIN = false;
    const float* x; float* h1; bf16_t* h1b; float* rowss;
    __device__ __forceinline__ void operator()(const f32x4 (&acc)[2][2][4][2], const Unit& u, int wr, int wc, int fr, int fq) const {
#pragma unroll
        for (int ai = 0; ai < 2; ++ai)
#pragma unroll
            for (int m = 0; m < 4; ++m) { const int row = u.pm * BM + ai * HALF + wr * 64 + m * 16 + fr; float ss = 0.f;
#pragma unroll
                for (int bj = 0; bj < 2; ++bj) { const size_t off = (size_t)row * DM + u.pn * BM + bj * HALF + wc * 32 + 8 * fq;
                    const f32x4 v0 = *(const f32x4*)(x + off) + acc[ai][bj][m][0], v1 = *(const f32x4*)(x + off + 4) + acc[ai][bj][m][1];
                    *(f32x4*)(h1 + off) = v0; *(f32x4*)(h1 + off + 4) = v1;
                    ss += (v0[0] * v0[0] + v0[1] * v0[1]) + (v0[2] * v0[2] + v0[3] * v0[3]) + (v1[0] * v1[0] + v1[1] * v1[1]) + (v1[2] * v1[2] + v1[3] * v1[3]);
                    u32x4 w; w.x = cvt_pk_bf16(v0[0], v0[1]); w.y = cvt_pk_bf16(v0[2], v0[3]); w.z = cvt_pk_bf16(v1[0], v1[1]); w.w = cvt_pk_bf16(v1[2], v1[3]);
                    *(u32x4*)(h1b + off) = w; }
                ss += __shfl_xor(ss, 16); ss += __shfl_xor(ss, 32);
                if (fq == 0) atomicAdd(rowss + row, ss); }
    }
};
struct EpiQ {
    static constexpr bool PERM = true, AFTER_DRAIN = false;
    bf16_t* Q; const float* rowss; float c;
    __device__ __forceinline__ void operator()(const f32x4 (&acc)[2][2][4][2], const Unit& u, int wr, int wc, int fr, int fq) const {
#pragma unroll
        for (int ai = 0; ai < 2; ++ai)
#pragma unroll
            for (int m = 0; m < 4; ++m) { const int row = u.pm * BM + ai * HALF + wr * 64 + m * 16 + fr;
                const float rs = c / sqrtf(rowss[row] * (1.0f / DM) + RMS_EPS);
#pragma unroll
                for (int bj = 0; bj < 2; ++bj) { const size_t off = (size_t)row * DM + u.pn * BM + bj * HALF + wc * 32 + 8 * fq;
                    const f32x4 v0 = acc[ai][bj][m][0] * rs, v1 = acc[ai][bj][m][1] * rs;
                    u32x4 w; w.x = cvt_pk_bf16(v0[0], v0[1]); w.y = cvt_pk_bf16(v0[2], v0[3]); w.z = cvt_pk_bf16(v1[0], v1[1]); w.w = cvt_pk_bf16(v1[2], v1[3]);
                    *(u32x4*)(Q + off) = w; } }
    }
};
struct SchedS {
    const char* q; const char* kb; int G, c;
    __device__ __forceinline__ bool next(int i, Unit& u) const { const int L = i * G + c; if (L >= 128) return false; u.pm = L >> 2; u.pn = L & 3; return true; }
    __device__ __forceinline__ const char* a_base(const Unit& u) const { return q + ((size_t)u.pm * BM * DM + (size_t)u.pn * XHD) * 2; }
    __device__ __forceinline__ const char* b_base(const Unit& u) const { return kb + (size_t)u.pn * XHD * 2; }
};
struct EpiSoftmax {
    static constexpr bool PERM = true, AFTER_DRAIN = true;
    bf16_t* P; float* lpart;
    __device__ __forceinline__ void fused(const f32x4 (&acc)[2][2][4][2], const Unit& u, int wr, int wc, int fr, int fq, PG8_LAS unsigned char* lds, int wid, int lane) const {
        PG8_LAS float* Pm = (PG8_LAS float*)lds;
#pragma unroll
        for (int ai = 0; ai < 2; ++ai)
#pragma unroll
            for (int m = 0; m < 4; ++m) { float mx = -3.0e38f;
#pragma unroll
                for (int bj = 0; bj < 2; ++bj)
#pragma unroll
                    for (int n = 0; n < 2; ++n) { const f32x4 v = acc[ai][bj][m][n]; mx = fmaxf(mx, fmaxf(fmaxf(v[0], v[1]), fmaxf(v[2], v[3]))); }
                mx = fmaxf(mx, __shfl_xor(mx, 16)); mx = fmaxf(mx, __shfl_xor(mx, 32));
                if (fq == 0) Pm[(ai * HALF + wr * 64 + m * 16 + fr) * 4 + wc] = mx; }
        asm volatile("s_waitcnt lgkmcnt(0)" ::: "memory"); __builtin_amdgcn_s_barrier(); asm volatile("" ::: "memory");
#pragma unroll
        for (int ai = 0; ai < 2; ++ai)
#pragma unroll
            for (int m = 0; m < 4; ++m) { const int r = ai * HALF + wr * 64 + m * 16 + fr; const int row = u.pm * BM + r;
                const f32x4 pm4 = *(const PG8_LAS f32x4*)(Pm + r * 4); const float mx = fmaxf(fmaxf(pm4[0], pm4[1]), fmaxf(pm4[2], pm4[3]));
                float l = 0.f;
#pragma unroll
                for (int bj = 0; bj < 2; ++bj) { f32x4 v0 = acc[ai][bj][m][0], v1 = acc[ai][bj][m][1];
#pragma unroll
                    for (int e = 0; e < 4; ++e) { v0[e] = __builtin_amdgcn_exp2f(v0[e] - mx); v1[e] = __builtin_amdgcn_exp2f(v1[e] - mx); }
                    l += (v0[0] + v0[1]) + (v0[2] + v0[3]) + (v1[0] + v1[1]) + (v1[2] + v1[3]);
                    u32x4 w; w.x = cvt_pk_bf16(v0[0], v0[1]); w.y = cvt_pk_bf16(v0[2], v0[3]); w.z = cvt_pk_bf16(v1[0], v1[1]); w.w = cvt_pk_bf16(v1[2], v1[3]);
                    *(u32x4*)(P + (size_t)row * 1024 + u.pn * 256 + bj * HALF + wc * 32 + 8 * fq) = w; }
                l += __shfl_xor(l, 16); l += __shfl_xor(l, 32);
                if (fq == 0) lpart[(size_t)row * 16 + u.pn * 4 + wc] = l; }
    }
};
struct SchedO {
    const char* p; const char* vt; int G, c;
    __device__ __forceinline__ bool next(int i, Unit& u) const { const int L = i * G + c; if (L >= 256) return false; u.pm = L >> 3; u.pn = L & 7; return true; }
    __device__ __forceinline__ const char* a_base(const Unit& u) const { return p + ((size_t)u.pm * BM * 1024 + (size_t)(u.pn >> 1) * 256) * 2; }
    __device__ __forceinline__ const char* b_base(const Unit& u) const { return vt + (size_t)u.pn * BM * 256 * 2; }
};
struct EpiO {
    static constexpr bool PERM = true, AFTER_DRAIN = false;
    bf16_t* O; const float* lpart;
    __device__ __forceinline__ void operator()(const f32x4 (&acc)[2][2][4][2], const Unit& u, int wr, int wc, int fr, int fq) const {
#pragma unroll
        for (int ai = 0; ai < 2; ++ai)
#pragma unroll
            for (int m = 0; m < 4; ++m) { const int row = u.pm * BM + ai * HALF + wr * 64 + m * 16 + fr;
                const f32x4 lp = *(const f32x4*)(lpart + (size_t)row * 16 + (u.pn >> 1) * 4); const float inv = 1.0f / ((lp[0] + lp[1]) + (lp[2] + lp[3]));
#pragma unroll
                for (int bj = 0; bj < 2; ++bj) { const size_t off = (size_t)row * DM + u.pn * BM + bj * HALF + wc * 32 + 8 * fq;
                    const f32x4 v0 = acc[ai][bj][m][0] * inv, v1 = acc[ai][bj][m][1] * inv;
                    u32x4 w; w.x = cvt_pk_bf16(v0[0], v0[1]); w.y = cvt_pk_bf16(v0[2], v0[3]); w.z = cvt_pk_bf16(v1[0], v1[1]); w.w = cvt_pk_bf16(v1[2], v1[3]);
                    *(u32x4*)(O + off) = w; } }
    }
};
struct EpiRes2 {
    static constexpr bool PERM = true, AFTER_DRAIN = false;
    float* out;
    __device__ __forceinline__ void operator()(const f32x4 (&acc)[2][2][4][2], const Unit& u, int wr, int wc, int fr, int fq) const {
#pragma unroll
        for (int ai = 0; ai < 2; ++ai)
#pragma unroll
            for (int m = 0; m < 4; ++m) { const int row = u.pm * BM + ai * HALF + wr * 64 + m * 16 + fr;
#pragma unroll
                for (int bj = 0; bj < 2; ++bj) { const size_t off = (size_t)row * DM + u.pn * BM + bj * HALF + wc * 32 + 8 * fq;
                    const f32x4 v0 = *(const f32x4*)(out + off) + acc[ai][bj][m][0], v1 = *(const f32x4*)(out + off + 4) + acc[ai][bj][m][1];
                    *(f32x4*)(out + off) = v0; *(f32x4*)(out + off + 4) = v1; } }
    }
};
}

__device__ __forceinline__ void p0_transpose_item(const float* W, int K, int N, bf16* WT, int row_off, const float* g, LAS float* scr, int item, int lane) {
    const int nblk = N / 32, kb = item / nblk, nb = item % nblk, k0 = 64 * kb, n0 = 32 * nb;
#pragma unroll 8
    for (int i = 0; i < 32; ++i) { const int kk = 2 * i + (lane >> 5); float v = W[(size_t)(k0 + kk) * N + n0 + (lane & 31)]; if (g) v *= g[k0 + kk]; scr[kk * 33 + (lane & 31)] = v; }
    LDS_WAIT(); asm volatile("" ::: "memory");
    const int c = lane & 7;
#pragma unroll
    for (int j = 0; j < 4; ++j) { const int n = (lane >> 3) + 8 * j; const LAS float* s = scr + (8 * c) * 33 + n;
        v4u o; o.x = pk2(s[0 * 33], s[1 * 33]); o.y = pk2(s[2 * 33], s[3 * 33]); o.z = pk2(s[4 * 33], s[5 * 33]); o.w = pk2(s[6 * 33], s[7 * 33]);
        *(v4u*)(WT + (size_t)(row_off + n0 + n) * K + k0 + 8 * c) = o; }
    LDS_WAIT(); asm volatile("" ::: "memory");
}
__device__ __forceinline__ void rms_row_to_bf16(const float* xrow, const float* g, bf16* orow, int lane) {
    const f32x4* xr = (const f32x4*)xrow + lane; const f32x4* gr = (const f32x4*)g + lane;
    f32x4 v[8]; float s = 0.f;
#pragma unroll
    for (int j = 0; j < 8; ++j) { v[j] = xr[64 * j]; s += (v[j][0] * v[j][0] + v[j][1] * v[j][1]) + (v[j][2] * v[j][2] + v[j][3] * v[j][3]); }
    const float rstd = 1.0f / sqrtf(wave_sum(s) * (1.0f / DM) + RMS_EPS);
    v2u* o8 = (v2u*)orow + lane;
#pragma unroll
    for (int j = 0; j < 8; ++j) { const f32x4 gg = gr[64 * j]; v2u o; o.x = pk2(v[j][0] * rstd * gg[0], v[j][1] * rstd * gg[1]); o.y = pk2(v[j][2] * rstd * gg[2], v[j][3] * rstd * gg[3]); o8[64 * j] = o; }
}
__device__ __forceinline__ void p0_prologue(Frame& F) {
    LAS float* scr = (LAS float*)(F.lds + F.wave * 16384);
    const int gw = F.vcu * NWAVES + F.wave, NGW = F.G * NWAVES;
    bf16* Win_t = (bf16*)(F.ws + WS_WIN); bf16* Wout_t = (bf16*)(F.ws + WS_WOUT); bf16* Wq_t = (bf16*)(F.ws + WS_WQ); bf16* Wkv_t = (bf16*)(F.ws + WS_WKV); bf16* Wo_t = (bf16*)(F.ws + WS_WO); bf16* Wg_t = (bf16*)(F.ws + WS_WG);
    constexpr int I_IN = (DM / 64) * (INC / 32), I_OUT = (MIXW / 64) * (DM / 32), I_Q = (DM / 64) * (DM / 32), I_KV = (DM / 64) * (2 * DM / 32), I_O = I_Q, I_G = 2 * NHB * 8;
    constexpr int NITEMS = I_IN + I_OUT + I_Q + I_KV + I_O + I_G;
    for (int m = gw; m < SEQ; m += NGW) rms_row_to_bf16(F.x + (size_t)m * DM, F.g_mix, (bf16*)(F.ws + WS_XN) + (size_t)m * DM, F.lane);
    for (int m = gw; m < NMEM; m += NGW) rms_row_to_bf16(F.mem + (size_t)m * DM, F.g_mem, (bf16*)(F.ws + WS_MN) + (size_t)m * DM, F.lane);
    for (int it = gw; it < NITEMS; it += NGW) {
        int r = it;
        if (r < I_IN) { p0_transpose_item(F.w_in, DM, INC, Win_t, 0, nullptr, scr, r, F.lane); continue; } r -= I_IN;
        if (r < I_OUT) { p0_transpose_item(F.w_out, MIXW, DM, Wout_t, 0, nullptr, scr, r, F.lane); continue; } r -= I_OUT;
        if (r < I_Q) { p0_transpose_item(F.w_q, DM, DM, Wq_t, 0, F.g_x, scr, r, F.lane); continue; } r -= I_Q;
        if (r < I_KV) { p0_transpose_item(F.w_kv, DM, 2 * DM, Wkv_t, 0, nullptr, scr, r, F.lane); continue; } r -= I_KV;
        if (r < I_O) { p0_transpose_item(F.w_o, DM, DM, Wo_t, 0, nullptr, scr, r, F.lane); continue; } r -= I_O;
        { const int gate = r / (NHB * 8), hh = (r / 8) % NHB, sub = r % 8;
          p0_transpose_item((gate ? F.w_i : F.w_r) + (size_t)hh * HD * HD, HD, HD, Wg_t + (size_t)hh * 256 * HD, gate * HD, nullptr, scr, sub, F.lane); }
    }
    float* rowss = (float*)(F.ws + WS_ROWSS);
    for (int i = F.vcu * NWAVES * 64 + F.tid; i < SEQ; i += F.G * NWAVES * 64) rowss[i] = 0.f;
}

__device__ __forceinline__ void conva_unit(Frame& F, int cidx) {
    const bf16* proj = (const bf16*)(F.ws + WS_PROJ); bf16* ycat = (bf16*)(F.ws + WS_YCAT);
    const int chb = (F.tid & 255) * 8, tstart = cidx * 32 + (F.tid >> 8) * 16;
    f32x4 w0[2], w1[2], w2[2], bb[2], cm2[2], cm1[2];
#pragma unroll
    for (int e = 0; e < 2; ++e) { w0[e] = *(const f32x4*)(F.caw + chb + 4 * e); w1[e] = *(const f32x4*)(F.caw + DM + chb + 4 * e); w2[e] = *(const f32x4*)(F.caw + 2 * DM + chb + 4 * e); bb[e] = *(const f32x4*)(F.cab + chb + 4 * e);
        cm2[e] = (f32x4){0.f, 0.f, 0.f, 0.f}; cm1[e] = cm2[e]; }
#pragma unroll
    for (int k = 0; k < 2; ++k) { const int tt = tstart - 2 + k;
        if (tt >= 0) { const v4u v = *(const v4u*)(proj + (size_t)tt * INC + chb), c = *(const v4u*)(proj + (size_t)tt * INC + 2 * DM + chb);
            f32x4 c0 = (f32x4){bflo(c.x) * bflo(v.x), bfhi(c.x) * bfhi(v.x), bflo(c.y) * bflo(v.y), bfhi(c.y) * bfhi(v.y)};
            f32x4 c1 = (f32x4){bflo(c.z) * bflo(v.z), bfhi(c.z) * bfhi(v.z), bflo(c.w) * bflo(v.w), bfhi(c.w) * bfhi(v.w)};
            if (k == 0) { cm2[0] = c0; cm2[1] = c1; } else { cm1[0] = c0; cm1[1] = c1; } } }
#pragma unroll 4
    for (int r = 0; r < 16; ++r) { const size_t ro = (size_t)(tstart + r) * INC + chb;
        const v4u v = *(const v4u*)(proj + ro), b = *(const v4u*)(proj + ro + DM), c = *(const v4u*)(proj + ro + 2 * DM), g = *(const v4u*)(proj + ro + 3 * DM);
        const f32x4 c0 = (f32x4){bflo(c.x) * bflo(v.x), bfhi(c.x) * bfhi(v.x), bflo(c.y) * bflo(v.y), bfhi(c.y) * bfhi(v.y)};
        const f32x4 c1 = (f32x4){bflo(c.z) * bflo(v.z), bfhi(c.z) * bfhi(v.z), bflo(c.w) * bflo(v.w), bfhi(c.w) * bfhi(v.w)};
        const f32x4 cv0 = bb[0] + w0[0] * cm2[0] + w1[0] * cm1[0] + w2[0] * c0, cv1 = bb[1] + w0[1] * cm2[1] + w1[1] * cm1[1] + w2[1] * c1;
        const f32x4 g0 = (f32x4){bflo(g.x), bfhi(g.x), bflo(g.y), bfhi(g.y)}, g1 = (f32x4){bflo(g.z), bfhi(g.z), bflo(g.w), bfhi(g.w)};
        const f32x4 b0 = (f32x4){bflo(b.x), bfhi(b.x), bflo(b.y), bfhi(b.y)}, b1 = (f32x4){bflo(b.z), bfhi(b.z), bflo(b.w), bfhi(b.w)};
        f32x4 y0, y1;
#pragma unroll
        for (int e = 0; e < 4; ++e) { y0[e] = b0[e] * cv0[e] * g0[e] * sigmoidf_(g0[e]); y1[e] = b1[e] * cv1[e] * g1[e] * sigmoidf_(g1[e]); }
        v4u o; o.x = pk2(y0[0], y0[1]); o.y = pk2(y0[2], y0[3]); o.z = pk2(y1[0], y1[1]); o.w = pk2(y1[2], y1[3]);
        *(v4u*)(ycat + (size_t)(tstart + r) * MIXW + chb) = o;
        cm2[0] = cm1[0]; cm2[1] = cm1[1]; cm1[0] = c0; cm1[1] = c1; }
}

constexpr int SC_RAW = 0, SC_RAWS = 272, SC_XB = 18432, SC_XBS = 272, SC_XF = 35840, SC_XFS = 528, SC_GT = 69632, SC_GTS = 272, SC_GTB = 17408;
constexpr int NGRP = SEQ / 512;
__device__ __forceinline__ float fast_sigmoid(float x) { return __builtin_amdgcn_rcpf(1.0f + __builtin_amdgcn_exp2f(-1.4426950408889634f * x)); }
template <int PASS>
__device__ __forceinline__ void scan_super(Frame& F, int g, int h) {
    LAS unsigned char* L = F.lds;
    const bf16* proj = (const bf16*)(F.ws + WS_PROJ);
    const int tid = F.tid, lane = F.lane, w = F.wave, fr = lane & 15, fq = lane >> 4;
    const int chl = w * 16 + fr, ch = h * HD + chl;
    const int cg8 = tid & 15, r0 = tid >> 4, chb = h * HD + cg8 * 8;
    f32x4 wk[4][2], bb[2];
#pragma unroll
    for (int k = 0; k < 4; ++k) { wk[k][0] = *(const f32x4*)(F.cbw + k * DM + chb); wk[k][1] = *(const f32x4*)(F.cbw + k * DM + chb + 4); }
    bb[0] = *(const f32x4*)(F.cbb + chb); bb[1] = *(const f32x4*)(F.cbb + chb + 4);
    const bf16* wg = (const bf16*)(F.ws + WS_WG) + ((size_t)(h * 256 + chl)) * HD + fq * 8;
    bf16x8 br[4], bi[4];
#pragma unroll
    for (int ks = 0; ks < 4; ++ks) { br[ks] = *(const bf16x8*)(wg + ks * 32); bi[ks] = *(const bf16x8*)(wg + HD * HD + ks * 32); }
    const float brg = F.b_r[ch], big = F.b_i[ch], c8l = -8.0f * 1.4426950408889634f * log1pf(expf(-F.lam[ch]));
    float hcar = 0.f, Pacc = 1.f;
    if (PASS == 1) { const f32x2* ag = (const f32x2*)(F.ws + WS_AGG) + ch;
        for (int gg = 0; gg < g; ++gg) { const f32x2 v = ag[(size_t)gg * DM]; hcar = v[0] * hcar + v[1]; } }
    v4u pr[3], pg[2];
#define SC_LOADTILE(T0) do { _Pragma("unroll") for (int i_ = 0; i_ < 3; ++i_) { const int p_ = tid + i_ * 512, tt_ = (T0) - 3 + (p_ >> 4); pr[i_] = (v4u){0u, 0u, 0u, 0u}; \
        if (p_ < 1072 && tt_ >= 0) pr[i_] = *(const v4u*)(proj + (size_t)tt_ * INC + 4 * DM + h * HD + (p_ & 15) * 8); } \
        if (PASS == 1) { _Pragma("unroll") for (int i_ = 0; i_ < 2; ++i_) { const int p_ = tid + i_ * 512; pg[i_] = *(const v4u*)(proj + (size_t)((T0) + (p_ >> 4)) * INC + 5 * DM + h * HD + (p_ & 15) * 8); } } } while (0)
    SC_LOADTILE(g * 512);
    for (int cc = 0; cc < 8; ++cc) {
        const int t0 = g * 512 + cc * 64; const int gtb = SC_GT + (cc & 1) * SC_GTB;
#pragma unroll
        for (int i = 0; i < 3; ++i) { const int p = tid + i * 512; if (p < 1072) *(LAS v4u*)(L + SC_RAW + (p >> 4) * SC_RAWS + (p & 15) * 16) = pr[i]; }
        if (PASS == 1) {
#pragma unroll
            for (int i = 0; i < 2; ++i) { const int p = tid + i * 512; *(LAS v4u*)(L + gtb + (p >> 4) * SC_GTS + (p & 15) * 16) = pg[i]; } }
        __syncthreads();
        if (cc < 7) SC_LOADTILE(t0 + 64);
#pragma unroll
        for (int it = 0; it < 2; ++it) { const int r = r0 + it * 32;
            f32x4 a0 = bb[0], a1 = bb[1];
#pragma unroll
            for (int k = 0; k < 4; ++k) { const v4u v = *(const LAS v4u*)(L + SC_RAW + (r + k) * SC_RAWS + cg8 * 16);
                a0 += wk[k][0] * (f32x4){bflo(v.x), bfhi(v.x), bflo(v.y), bfhi(v.y)}; a1 += wk[k][1] * (f32x4){bflo(v.z), bfhi(v.z), bflo(v.w), bfhi(v.w)}; }
            v4u o; o.x = pk2(a0[0], a0[1]); o.y = pk2(a0[2], a0[3]); o.z = pk2(a1[0], a1[1]); o.w = pk2(a1[2], a1[3]);
            *(LAS v4u*)(L + SC_XB + r * SC_XBS + cg8 * 16) = o;
            *(LAS f32x4*)(L + SC_XF + r * SC_XFS + cg8 * 32) = a0; *(LAS f32x4*)(L + SC_XF + r * SC_XFS + cg8 * 32 + 16) = a1; }
        __syncthreads();
        f32x4 ar[4], ai[4];
#pragma unroll
        for (int rb = 0; rb < 4; ++rb) { ar[rb] = (f32x4){0.f, 0.f, 0.f, 0.f}; ai[rb] = ar[rb];
#pragma unroll
            for (int ks = 0; ks < 4; ++ks) { const bf16x8 a = *(const LAS bf16x8*)(L + SC_XB + (rb * 16 + fr) * SC_XBS + (ks * 32 + fq * 8) * 2);
                ar[rb] = __builtin_amdgcn_mfma_f32_16x16x32_bf16(a, br[ks], ar[rb], 0, 0, 0); ai[rb] = __builtin_amdgcn_mfma_f32_16x16x32_bf16(a, bi[ks], ai[rb], 0, 0, 0); } }
        f32x4 Pv[4], Hv[4];
#pragma unroll
        for (int rb = 0; rb < 4; ++rb) { float Pc = 1.f, Hc = 0.f;
#pragma unroll
            for (int idx = 0; idx < 4; ++idx) { const int tl = rb * 16 + fq * 4 + idx;
                const float xc = *(const LAS float*)(L + SC_XF + tl * SC_XFS + chl * 4);
                const float r = fast_sigmoid(ar[rb][idx] + brg), ig = fast_sigmoid(ai[rb][idx] + big);
                const float a = __builtin_amdgcn_exp2f(c8l * r); float mult = __builtin_amdgcn_sqrtf(fmaxf(1.0f - a * a, 0.f)); if (t0 + tl == 0) mult = 1.0f;
                const float uu = mult * ig * xc;
                Hc = a * Hc + uu; Pc *= a; Pv[rb][idx] = Pc; Hv[rb][idx] = Hc; } }
#pragma unroll
        for (int rb = 0; rb < 4; ++rb) {
            float Pt = Pv[rb][3], Ht = Hv[rb][3];
            float Pp = __shfl_up(Pt, 16), Hp = __shfl_up(Ht, 16); if (fq >= 1) { Ht = Pt * Hp + Ht; Pt = Pt * Pp; }
            Pp = __shfl_up(Pt, 32); Hp = __shfl_up(Ht, 32); if (fq >= 2) { Ht = Pt * Hp + Ht; Pt = Pt * Pp; }
            float Pe = __shfl_up(Pt, 16), He = __shfl_up(Ht, 16); if (fq == 0) { Pe = 1.f; He = 0.f; }
            const float Ptot = __shfl(Pt, fr + 48), Htot = __shfl(Ht, fr + 48);
            if (PASS == 1) { const float hent = Pe * hcar + He;
#pragma unroll
                for (int idx = 0; idx < 4; ++idx) { const int tl = rb * 16 + fq * 4 + idx; const float hv = Pv[rb][idx] * hent + Hv[rb][idx];
                    LAS unsigned short* gp = (LAS unsigned short*)(L + gtb + tl * SC_GTS + chl * 2);
                    const float gg = __builtin_bit_cast(float, (unsigned)(*gp) << 16); const float y = hv * gg * fast_sigmoid(gg);
                    *gp = (unsigned short)(pk2(y, 0.f) & 0xffffu); } }
            hcar = Ptot * hcar + Htot; Pacc *= Ptot;
        }
        if (PASS == 1) { __syncthreads();
            bf16* ycat = (bf16*)(F.ws + WS_YCAT);
#pragma unroll
            for (int it = 0; it < 2; ++it) { const int r = r0 + it * 32;
                *(v4u*)(ycat + (size_t)(t0 + r) * MIXW + DM + h * HD + cg8 * 8) = *(const LAS v4u*)(L + gtb + r * SC_GTS + cg8 * 16); } }
    }
#undef SC_LOADTILE
    if (PASS == 0) { if (fq == 0) *((f32x2*)(F.ws + WS_AGG) + (size_t)g * DM + ch) = (f32x2){Pacc, hcar}; }
    __syncthreads();
}

__device__ __forceinline__ void final_norm_row(float* row, const float* g, int lane) {
    f32x4* xr = (f32x4*)row + lane; const f32x4* gr = (const f32x4*)g + lane;
    f32x4 v[8]; float s = 0.f;
#pragma unroll
    for (int j = 0; j < 8; ++j) { v[j] = xr[64 * j]; s += (v[j][0] * v[j][0] + v[j][1] * v[j][1]) + (v[j][2] * v[j][2] + v[j][3] * v[j][3]); }
    const float rstd = 1.0f / sqrtf(wave_sum(s) * (1.0f / DM) + RMS_EPS);
#pragma unroll
    for (int j = 0; j < 8; ++j) xr[64 * j] = v[j] * rstd * gr[64 * j];
}

__global__ void __launch_bounds__(NWAVES * 64, 2) hymba_fwd(Args args) {
    extern __shared__ __attribute__((aligned(16))) unsigned char lds[];
    cg::grid_group grid = cg::this_grid();
    Frame F;
    F.lds = (LAS unsigned char*)lds;
    F.tid = threadIdx.x; F.lane = F.tid & 63; F.wave = __builtin_amdgcn_readfirstlane(F.tid >> 6);
    F.G = gridDim.x; { const int bx = blockIdx.x; F.vcu = (F.G % 8 == 0) ? (bx % 8) * (F.G / 8) + bx / 8 : bx; }
    F.x = args.in[0]; F.mem = args.in[1]; F.g_mix = args.in[2]; F.w_in = args.in[3]; F.caw = args.in[4]; F.cab = args.in[5]; F.cbw = args.in[6]; F.cbb = args.in[7];
    F.w_r = args.in[8]; F.b_r = args.in[9]; F.w_i = args.in[10]; F.b_i = args.in[11]; F.lam = args.in[12]; F.w_out = args.in[13]; F.g_x = args.in[14]; F.g_mem = args.in[15];
    F.w_q = args.in[16]; F.w_kv = args.in[17]; F.w_o = args.in[18]; F.g_f = args.in[19]; F.out = args.out; F.ws = args.ws;
    unsigned char* ws = args.ws;
    const int lo = args.ph_lo, hi = args.ph_hi;
    volatile LAS unsigned* MISC = (volatile LAS unsigned*)(F.lds + RING_BYTES + 64);
    if (F.tid < 2) MISC[F.tid] = 0u;
    __syncthreads();
    XcdBarrier bar = xcd_barrier_post((unsigned*)(ws + WS_BAR) + args.li * XCD_BAR_WORDS, MISC);
    if (lo < 0) grid.sync();
#define IN(k) (lo <= (k) && (k) < hi)
#define SEAM(k) do { if (IN(k) && IN((k) + 1)) xcd_barrier(bar); } while (0)

    if (IN(0)) { p0_prologue(F); }
    SEAM(0);
    if (IN(1)) {
        { pg8::Gemm g{DM, DM, DM}; pg8::SchedStd S; S.init(ws + WS_XN, DM, ws + WS_WIN, DM, SEQ, INC, F.G, (int)blockIdx.x);
          pg8::EpiProj E{(pg8::bf16_t*)(ws + WS_PROJ), INC};
          pg8::gemm_phase<pg8::EpiProj, pg8::SchedStd, true>(F.lds, g, S, E); }
        { pg8::Gemm g{DM, DM, DM}; pg8::SchedKV S{(const char*)(ws + WS_MN), (const char*)(ws + WS_WKV), F.G, (int)blockIdx.x};
          pg8::EpiKV E{(pg8::bf16_t*)(ws + WS_KB), (pg8::bf16_t*)(ws + WS_VT)};
          pg8::gemm_phase<pg8::EpiKV, pg8::SchedKV, true>(F.lds, g, S, E); }
    }
    SEAM(1);
    if (IN(2)) {
        for (int u = F.vcu; u < SEQ / 32; u += F.G) conva_unit(F, u);
        for (int u = F.vcu; u < NGRP * NHB; u += F.G) scan_super<0>(F, u >> 4, u & 15);
    }
    SEAM(2);
    if (IN(3)) {
        for (int u = F.vcu; u < NGRP * NHB; u += F.G) scan_super<1>(F, u >> 4, u & 15);
    }
    SEAM(3);
    if (IN(4)) {
        pg8::Gemm g{MIXW, MIXW, MIXW}; pg8::SchedStd S; S.init(ws + WS_YCAT, MIXW, ws + WS_WOUT, MIXW, SEQ, DM, F.G, (int)blockIdx.x);
        pg8::EpiRes1 E{F.x, F.out, (pg8::bf16_t*)(ws + WS_H1B), (float*)(ws + WS_ROWSS)};
        pg8::gemm_phase<pg8::EpiRes1, pg8::SchedStd, true>(F.lds, g, S, E);
    }
    SEAM(4);
    if (IN(5)) {
        pg8::Gemm g{DM, DM, DM}; pg8::SchedStd S; S.init(ws + WS_H1B, DM, ws + WS_WQ, DM, SEQ, DM, F.G, (int)blockIdx.x);
        pg8::EpiQ E{(pg8::bf16_t*)(ws + WS_Q), (const float*)(ws + WS_ROWSS), 0.04419417382415922f * 1.4426950408889634f};
        pg8::gemm_phase<pg8::EpiQ, pg8::SchedStd, true>(F.lds, g, S, E);
    }
    SEAM(5);
    if (IN(6)) {
        pg8::Gemm g{DM, DM, XHD}; pg8::SchedS S{(const char*)(ws + WS_Q), (const char*)(ws + WS_KB), F.G, (int)blockIdx.x};
        pg8::EpiSoftmax E{(pg8::bf16_t*)(ws + WS_P), (float*)(ws + WS_LP)};
        pg8::gemm_phase<pg8::EpiSoftmax, pg8::SchedS, false>(F.lds, g, S, E);
    }
    SEAM(6);
    if (IN(7)) {
        pg8::Gemm g{1024, 256, 256}; pg8::SchedO S{(const char*)(ws + WS_P), (const char*)(ws + WS_VT), F.G, (int)blockIdx.x};
        pg8::EpiO E{(pg8::bf16_t*)(ws + WS_O), (const float*)(ws + WS_LP)};
        pg8::gemm_phase<pg8::EpiO, pg8::SchedO, true>(F.lds, g, S, E);
    }
    SEAM(7);
    if (IN(8)) {
        pg8::Gemm g{DM, DM, DM}; pg8::SchedStd S; S.init(ws + WS_O, DM, ws + WS_WO, DM, SEQ, DM, F.G, (int)blockIdx.x);
        pg8::EpiRes2 E{F.out};
        pg8::gemm_phase<pg8::EpiRes2, pg8::SchedStd, true>(F.lds, g, S, E);
    }
    SEAM(8);
    if (IN(9)) {
        const int gw = F.vcu * NWAVES + F.wave, NGW = F.G * NWAVES;
        for (int m = gw; m < SEQ; m += NGW) final_norm_row(F.out + (size_t)m * DM, F.g_f, F.lane);
    }
#undef IN
#undef SEAM
}

extern "C" void kernel_launch(void* const* d_in, const int* in_sizes, int n_in, void* d_out, int out_size, void* d_ws, size_t ws_size, hipStream_t stream) {
    static int grid = 0;
    if (grid == 0) {
        if (n_in != 20 || out_size != SEQ * DM || ws_size < WS_END) { fprintf(stderr, "kernel_launch: unexpected shapes (n_in %d out %d ws %zu)\n", n_in, out_size, ws_size); grid = -1; return; }
        int dev = 0, cus = 0, per_cu = 0;
        if (hipGetDevice(&dev) != hipSuccess || hipDeviceGetAttribute(&cus, hipDeviceAttributeMultiprocessorCount, dev) != hipSuccess) { grid = -1; return; }
        if (hipFuncSetAttribute((const void*)hymba_fwd, hipFuncAttributeMaxDynamicSharedMemorySize, LDS_BYTES) != hipSuccess) { fprintf(stderr, "kernel_launch: hipFuncSetAttribute failed\n"); grid = -1; return; }
        if (hipOccupancyMaxActiveBlocksPerMultiprocessor(&per_cu, (const void*)hymba_fwd, NWAVES * 64, LDS_BYTES) != hipSuccess || per_cu < 1) { fprintf(stderr, "kernel_launch: occupancy query says %d\n", per_cu); }
        (void)hipGetLastError();
        grid = cus;
    }
    if (grid < 0) return;
    if (hipMemsetAsync((char*)d_ws, 0, CTL_ZERO_BYTES, stream) != hipSuccess) { fprintf(stderr, "kernel_launch: memset failed\n"); return; }
    Args a{};
    for (int i = 0; i < 20; ++i) a.in[i] = (const float*)d_in[i];
    a.out = (float*)d_out; a.ws = (unsigned char*)d_ws;
    static const int plan[][2] = PHASE_PLAN;
    for (int li = 0; li < (int)(sizeof(plan) / sizeof(plan[0])); ++li) {
        a.ph_lo = plan[li][0]; a.ph_hi = plan[li][1]; a.li = li;
        void* kargs[] = {&a};
        hipError_t e = hipLaunchCooperativeKernel((const void*)hymba_fwd, dim3(grid), dim3(NWAVES * 64), kargs, LDS_BYTES, stream);
        if (e != hipSuccess) { fprintf(stderr, "kernel_launch: cooperative launch %d failed: %s\n", li, hipGetErrorString(e)); break; }
    }
}
```

```cpp
#include <hip/hip_runtime.h>
#include <hip/hip_cooperative_groups.h>
#include <cstdio>
#include <cstdint>
namespace cg = cooperative_groups;

#define PHASE_PLAN {{0, 10}}

namespace pg8 {
#define PG8_LAS __attribute__((address_space(3)))
typedef unsigned short bf16_t;
typedef short bf16x8 __attribute__((ext_vector_type(8)));
typedef float f32x4 __attribute__((ext_vector_type(4)));
typedef unsigned u32x4 __attribute__((ext_vector_type(4)));
constexpr int BM = 256, BK = 64, HALF = 128, HTB = HALF * BK * 2, STAGE_BYTES = 8 * HTB, NXCD = 8, WGM = 8;

__host__ __device__ __forceinline__ int lds_byte(int r, int c) { const int st = (r >> 4) * 2 + (c >> 5), rr = r & 15, cc = c & 31, ob = rr * 64 + cc * 2; return st * 1024 + (ob ^ (((ob >> 9) & 1) << 5)); }
__host__ __device__ __forceinline__ void stage_rc(int b, int& R, int& C) { const int st = b / 1024, sb = b % 1024, swz = sb ^ (((sb >> 9) & 1) << 5); R = (st >> 1) * 16 + swz / 64; C = (st & 1) * 32 + (swz % 64) / 2; }
__host__ __device__ __forceinline__ int perm32(int rho) { const int n = rho >> 4, i = rho & 15; return 8 * (i >> 2) + 4 * n + (i & 3); }

struct Unit { int pm, pn; };
struct Gemm { int lda, ldb, K; };

__device__ __forceinline__ unsigned cvt_pk_bf16(float lo, float hi) { unsigned r; asm volatile("v_cvt_pk_bf16_f32 %0, %1, %2" : "=v"(r) : "v"(lo), "v"(hi)); return r; }

struct SchedStd {
    const char* A; const char* B; size_t strideA, strideB;
    int nM, nN, nwg, G, c;
    __device__ __forceinline__ void init(const void* A_, int lda, const void* B_, int ldb, int M, int N, int G_, int c_) {
        A = (const char*)A_; B = (const char*)B_; strideA = (size_t)BM * lda * 2; strideB = (size_t)BM * ldb * 2; nM = M / BM; nN = N / BM; nwg = nM * nN; G = G_; c = c_; }
    __device__ __forceinline__ bool next(int i, Unit& u) const {
        const long L = (long)i * G + c; if (L >= nwg) return false;
        int wgid = (int)L; { const int q = nwg / NXCD, r = nwg % NXCD, xcd = wgid % NXCD, off = wgid / NXCD; wgid = (xcd < r ? xcd * (q + 1) : r * (q + 1) + (xcd - r) * q) + off; }
        const int nig = WGM * nN, gid = wgid / nig, fm = gid * WGM, gsz = (nM - fm) < WGM ? (nM - fm) : WGM;
        u.pm = fm + ((wgid % nig) % gsz); u.pn = (wgid % nig) / gsz; return true;
    }
    __device__ __forceinline__ const char* a_base(const Unit& u) const { return A + (size_t)u.pm * strideA; }
    __device__ __forceinline__ const char* b_base(const Unit& u) const { return B + (size_t)u.pn * strideB; }
};

template <class Epi, class Sched, bool ALIGN_EPI>
__device__ __forceinline__ void gemm_phase(PG8_LAS unsigned char* lds, const Gemm g, const Sched& S, const Epi& E) {
    const int tid = threadIdx.x, wid = __builtin_amdgcn_readfirstlane(tid >> 6), lane = tid & 63, wr = wid >> 2, wc = wid & 3, fr = lane & 15, fq = lane >> 4;
    const int K = g.K, nt = K / BK;
    unsigned voffA[2], voffB[2];
#pragma unroll
    for (int i = 0; i < 2; ++i) { int R, C; stage_rc(tid * 16 + i * 8192, R, C); const int Rb = Epi::PERM ? ((R & ~31) + perm32(R & 31)) : R;
        voffA[i] = (unsigned)(R * g.lda + C) * 2u; voffB[i] = (unsigned)(Rb * g.ldb + C) * 2u; }
    const size_t kstep = (size_t)(BK * 2);
    const size_t hA = (size_t)HALF * g.lda * 2, hB = (size_t)HALF * g.ldb * 2;
    const unsigned ldsw = (unsigned)wid * 1024u;
    const int aoff = lds_byte(wr * 64 + fr, fq * 8), boff = lds_byte(wc * 32 + fr, fq * 8);
#define PG8_SA(b, h) (((b) * 2 + (h)) * HTB)
#define PG8_SB(b, h) ((4 + (b) * 2 + (h)) * HTB)
#define PG8_STAGE(bufoff, gbase, voff) do { _Pragma("unroll") for (int _i = 0; _i < 2; ++_i) \
        __builtin_amdgcn_global_load_lds((const unsigned*)((const char*)(gbase) + (voff)[_i]), (PG8_LAS unsigned*)(lds + (bufoff) + ldsw + _i * 8192), 16, 0, 0); } while (0)
#define PG8_LDA(dst, b, h) do { _Pragma("unroll") for (int m = 0; m < 4; ++m) _Pragma("unroll") for (int k = 0; k < 2; ++k) dst[m][k] = *(const PG8_LAS bf16x8*)(lds + PG8_SA(b, h) + aoff + m * 2048 + k * 1024); } while (0)
#define PG8_LDB(dst, b, h) do { _Pragma("unroll") for (int n = 0; n < 2; ++n) _Pragma("unroll") for (int k = 0; k < 2; ++k) dst[n][k] = *(const PG8_LAS bf16x8*)(lds + PG8_SB(b, h) + boff + n * 2048 + k * 1024); } while (0)
#define PG8_MMA(ai, bj, At, Bt) do { __builtin_amdgcn_s_setprio(1); _Pragma("unroll") for (int m = 0; m < 4; ++m) _Pragma("unroll") for (int n = 0; n < 2; ++n) _Pragma("unroll") for (int k = 0; k < 2; ++k) \
        acc[ai][bj][m][n] = __builtin_amdgcn_mfma_f32_16x16x32_bf16(Bt[n][k], At[m][k], acc[ai][bj][m][n], 0, 0, 0); __builtin_amdgcn_s_setprio(0); } while (0)
#define PG8_WAIT_V(n) asm volatile("s_waitcnt vmcnt(" #n ")" ::: "memory")
#define PG8_WAIT_L(n) asm volatile("s_waitcnt lgkmcnt(" #n ")" ::: "memory")
#define PG8_BAR __builtin_amdgcn_s_barrier()
#define PG8_SCHED __builtin_amdgcn_sched_barrier(0)
    Unit cur, nxt; int ui = 0;
    if (!S.next(0, cur)) return;
    f32x4 acc[2][2][4][2];
#pragma unroll
    for (int a = 0; a < 2; ++a)
#pragma unroll
        for (int b = 0; b < 2; ++b)
#pragma unroll
            for (int m = 0; m < 4; ++m)
#pragma unroll
                for (int n = 0; n < 2; ++n) acc[a][b][m][n] = (f32x4){0.f, 0.f, 0.f, 0.f};
    bf16x8 At[4][2], B0[2][2], B1[2][2];
    const char* cA = S.a_base(cur); const char* cB = S.b_base(cur);
    PG8_STAGE(PG8_SB(0, 0), cB, voffB); PG8_STAGE(PG8_SB(0, 1), cB + hB, voffB); PG8_STAGE(PG8_SA(0, 0), cA, voffA); PG8_STAGE(PG8_SA(0, 1), cA + hA, voffA);
    if (wr == 1) PG8_BAR;
    PG8_WAIT_V(2); PG8_BAR;
    PG8_STAGE(PG8_SB(1, 0), cB + kstep, voffB); PG8_STAGE(PG8_SA(1, 0), cA + kstep, voffA); PG8_STAGE(PG8_SB(1, 1), cB + hB + kstep, voffB);
    PG8_WAIT_V(6); PG8_BAR;
    for (;;) {
        const bool has_next = S.next(ui + 1, nxt);
        const char* nA = has_next ? S.a_base(nxt) : cA; const char* nB = has_next ? S.b_base(nxt) : cB;
        for (int t = 0; t < nt; t += 2) {
            const bool last = (t == nt - 2);
            const char* a1 = cA + (size_t)(t + 1) * kstep;
            const char* a2 = last ? nA : cA + (size_t)(t + 2) * kstep; const char* b2 = last ? nB : cB + (size_t)(t + 2) * kstep;
            const char* a3 = a2 + kstep; const char* b3 = b2 + kstep;
            PG8_LDB(B0, 0, 0); PG8_LDB(B1, 0, 1); PG8_SCHED; PG8_LDA(At, 0, 0); PG8_STAGE(PG8_SA(1, 1), a1 + hA, voffA);
            PG8_WAIT_V(8); PG8_WAIT_L(0); PG8_BAR; PG8_MMA(0, 0, At, B0); PG8_MMA(0, 1, At, B1); PG8_BAR; PG8_SCHED;
            PG8_LDA(At, 0, 1); PG8_STAGE(PG8_SB(0, 0), b2, voffB); PG8_STAGE(PG8_SB(0, 1), b2 + hB, voffB); PG8_STAGE(PG8_SA(0, 0), a2, voffA);
            PG8_WAIT_V(8); PG8_WAIT_L(0); PG8_BAR; PG8_MMA(1, 0, At, B0); PG8_MMA(1, 1, At, B1); PG8_BAR; PG8_SCHED;
            PG8_LDB(B0, 1, 0); PG8_LDB(B1, 1, 1); PG8_SCHED; PG8_LDA(At, 1, 0); PG8_STAGE(PG8_SA(0, 1), a2 + hA, voffA);
            PG8_WAIT_V(8); PG8_WAIT_L(0); PG8_BAR; PG8_MMA(0, 0, At, B0); PG8_MMA(0, 1, At, B1); PG8_BAR; PG8_SCHED;
            PG8_LDA(At, 1, 1); PG8_STAGE(PG8_SB(1, 0), b3, voffB); PG8_STAGE(PG8_SB(1, 1), b3 + hB, voffB); PG8_STAGE(PG8_SA(1, 0), a3, voffA);
            PG8_WAIT_V(8); PG8_WAIT_L(0); PG8_BAR; PG8_MMA(1, 0, At, B0); PG8_MMA(1, 1, At, B1); PG8_BAR; PG8_SCHED;
        }
        if constexpr (ALIGN_EPI) { if (wr == 0) PG8_BAR; }
        if constexpr (!Epi::AFTER_DRAIN) { E(acc, cur, wr, wc, fr, fq); }
        if (!has_next) break;
#pragma unroll
        for (int a = 0; a < 2; ++a)
#pragma unroll
            for (int b = 0; b < 2; ++b)
#pragma unroll
                for (int m = 0; m < 4; ++m)
#pragma unroll
                    for (int n = 0; n < 2; ++n) acc[a][b][m][n] = (f32x4){0.f, 0.f, 0.f, 0.f};
        cur = nxt; cA = nA; cB = nB; ++ui;
        if constexpr (ALIGN_EPI) { if (wr == 1) PG8_BAR; }
    }
    PG8_WAIT_V(0);
    if constexpr (!ALIGN_EPI) { if (wr == 0) PG8_BAR; }
    PG8_BAR;
    if constexpr (Epi::AFTER_DRAIN) { E.fused(acc, cur, wr, wc, fr, fq, lds, wid, lane); }
#undef PG8_SA
#undef PG8_SB
#undef PG8_STAGE
#undef PG8_LDA
#undef PG8_LDB
#undef PG8_MMA
#undef PG8_WAIT_V
#undef PG8_WAIT_L
#undef PG8_BAR
#undef PG8_SCHED
}
}

constexpr int NWAVES = 8;
constexpr int SEQ = 8192, DM = 2048, NMEM = 256, INC = 12288, MIXW = 4096, NHB = 16, HD = 128, XH = 4, XHD = 512;
constexpr float RMS_EPS = 1e-6f;
constexpr int N_PHASES = 10;

constexpr size_t MiB = 1u << 20;
constexpr size_t WS_ROWSS = 0;
constexpr size_t WS_BAR = 65536;
constexpr size_t CTL_ZERO_BYTES = 131072;
constexpr size_t WS_WG = 1 * MiB;
constexpr size_t WS_MN = 2 * MiB;
constexpr size_t WS_KB = 3 * MiB;
constexpr size_t WS_VT = 4 * MiB;
constexpr size_t WS_AGG = 5 * MiB;
constexpr size_t WS_LP = 7 * MiB;
constexpr size_t WS_WOUT = 8 * MiB;
constexpr size_t WS_WQ = 24 * MiB;
constexpr size_t WS_WO = 32 * MiB;
constexpr size_t WS_WIN = 40 * MiB;
constexpr size_t WS_WKV = 88 * MiB;
constexpr size_t WS_XN = 104 * MiB;
constexpr size_t WS_YCAT = 40 * MiB;
constexpr size_t WS_PROJ = 136 * MiB;
constexpr size_t WS_H1B = 136 * MiB;
constexpr size_t WS_Q = 168 * MiB;
constexpr size_t WS_P = 200 * MiB;
constexpr size_t WS_O = 216 * MiB;
constexpr size_t WS_END = 328 * MiB;

constexpr int RING_BYTES = 131072;
constexpr int LDS_BYTES = 147456;

#define GAS __attribute__((address_space(1)))
#define LAS __attribute__((address_space(3)))
typedef unsigned short bf16;
typedef unsigned v4u __attribute__((ext_vector_type(4)));
typedef unsigned v2u __attribute__((ext_vector_type(2)));
typedef float f32x4 __attribute__((ext_vector_type(4)));
typedef float f32x2 __attribute__((ext_vector_type(2)));
typedef short bf16x8 __attribute__((ext_vector_type(8)));
#define LDS_WAIT() asm volatile("s_waitcnt lgkmcnt(0)" ::: "memory")

__device__ __forceinline__ unsigned pk2(float lo, float hi) { return pg8::cvt_pk_bf16(lo, hi); }
__device__ __forceinline__ float bflo(unsigned v) { return __builtin_bit_cast(float, v << 16); }
__device__ __forceinline__ float bfhi(unsigned v) { return __builtin_bit_cast(float, v & 0xffff0000u); }
__device__ __forceinline__ float wave_sum(float v) {
#pragma unroll
    for (int o = 1; o < 64; o <<= 1) v += __shfl_xor(v, o);
    return v;
}
__device__ __forceinline__ float sigmoidf_(float x) { return __builtin_amdgcn_rcpf(1.0f + __builtin_amdgcn_exp2f(-1.4426950408889634f * x)); }


#define XB_TMO      128
#define XB_XCNT(j)  (256  + 64 * (j))
#define XB_XSUB(j)  (1280 + 64 * (j))
#define XB_XGEN(j)  (2304 + 64 * (j))
#define XB_TOP      3328
#define XB_TOPGEN   3392
#define XCD_BAR_WORDS 3456
#define XB_SPIN_CAP (1u << 18)
__device__ __forceinline__ unsigned xb_ld(unsigned* p)              { return __hip_atomic_load(p, __ATOMIC_RELAXED, __HIP_MEMORY_SCOPE_AGENT); }
__device__ __forceinline__ unsigned xb_add(unsigned* p, unsigned v) { return __hip_atomic_fetch_add(p, v, __ATOMIC_RELAXED, __HIP_MEMORY_SCOPE_AGENT); }
__device__ __forceinline__ unsigned xb_xcc_id() { return (unsigned)__builtin_amdgcn_s_getreg((3 << 11) | 20) & 0xFu; }
#define XB_SPIN(cond, bar) do { unsigned _sp = 0; while (cond) { __builtin_amdgcn_s_sleep(1); \
    if ((++_sp & 255u) == 0u) { if (xb_ld(&(bar)[XB_TMO])) break; if (_sp > XB_SPIN_CAP) { atomicAdd(&(bar)[XB_TMO], 1u); break; } } } } while (0)
struct XcdBarrier { unsigned* bar; unsigned x; volatile LAS unsigned* st; };
__device__ __forceinline__ XcdBarrier xcd_barrier_post(unsigned* bar, volatile LAS unsigned* st) {
    XcdBarrier b; b.bar = bar; b.x = xb_xcc_id(); b.st = st;
    if (threadIdx.x == 0) (void)xb_add(&bar[XB_XCNT(b.x)], 1u);
    return b;
}
__device__ __forceinline__ void xcd_barrier_complete(unsigned* bar, unsigned x, unsigned& nloc, unsigned& nx) {
    const unsigned G = gridDim.x * gridDim.y * gridDim.z;
    unsigned sum, cnt, mine, sp = 0u;
    for (;;) {
        sum = 0u; cnt = 0u; mine = 0u;
#pragma unroll
        for (unsigned j = 0; j < 16; ++j) { const unsigned c = xb_ld(&bar[XB_XCNT(j)]); sum += c; cnt += (c > 0u) ? 1u : 0u; mine = (j == x) ? c : mine; }
        if (sum == G) break;
        __builtin_amdgcn_s_sleep(1);
        if ((++sp & 255u) == 0u) { if (xb_ld(&bar[XB_TMO])) break; if (sp > XB_SPIN_CAP) { atomicAdd(&bar[XB_TMO], 1u); break; } }
    }
    nloc = mine > 0u ? mine : 1u; nx = cnt > 0u ? cnt : 1u;
}
__device__ __forceinline__ void xcd_barrier(const XcdBarrier& b) {
    asm volatile("s_waitcnt vmcnt(0)" ::: "memory");
    __syncthreads();
    if (threadIdx.x == 0) {
        unsigned* bar = b.bar;
        __builtin_amdgcn_s_waitcnt(0);
        unsigned nloc = b.st[0], nx = b.st[1];
        if (nloc == 0u) { xcd_barrier_complete(bar, b.x, nloc, nx); b.st[0] = nloc; b.st[1] = nx; }
        const unsigned old = xb_add(&bar[XB_XSUB(b.x)], 1u);
        const unsigned gen = old / nloc;
        if (old + 1u == (gen + 1u) * nloc) {
            __builtin_amdgcn_fence(__ATOMIC_RELEASE, "agent");
            asm volatile("s_waitcnt vmcnt(0)" ::: "memory");
            const unsigned og = xb_add(&bar[XB_TOP], 1u);
            const unsigned tg = og / nx;
            if (og + 1u == (tg + 1u) * nx) xb_add(&bar[XB_TOPGEN], 1u);
            else XB_SPIN(xb_ld(&bar[XB_TOPGEN]) == tg, bar);
            __builtin_amdgcn_fence(__ATOMIC_ACQUIRE, "agent");
            xb_add(&bar[XB_XGEN(b.x)], 1u);
            asm volatile("s_waitcnt vmcnt(0)" ::: "memory");
        } else {
            XB_SPIN(xb_ld(&bar[XB_XGEN(b.x)]) == gen, bar);
            __builtin_amdgcn_fence(__ATOMIC_ACQUIRE, "agent");
            asm volatile("s_waitcnt vmcnt(0)" ::: "memory");
        }
    }
    __syncthreads();
}

struct Args {
    const float* in[20]; float* out; unsigned char* ws; int ph_lo, ph_hi, li, pad;
};

struct Frame {
    LAS unsigned char* lds;
    int tid, lane, wave, vcu, G;
    const float *x, *mem, *g_mix, *w_in, *caw, *cab, *cbw, *cbb, *w_r, *b_r, *w_i, *b_i, *lam, *w_out, *g_x, *g_mem, *w_q, *w_kv, *w_o, *g_f;
    float* out; unsigned char* ws;
};

namespace pg8 {
__device__ __forceinline__ void store_tile_bf16(const f32x4 (&acc)[2][2][4][2], bf16_t* tile, int ldc, int wr, int wc, int fr, int fq) {
#pragma unroll
    for (int ai = 0; ai < 2; ++ai)
#pragma unroll
        for (int m = 0; m < 4; ++m) { bf16_t* rowp = tile + (size_t)(ai * HALF + wr * 64 + m * 16 + fr) * ldc + wc * 32 + 8 * fq;
#pragma unroll
            for (int bj = 0; bj < 2; ++bj) { const f32x4 v0 = acc[ai][bj][m][0], v1 = acc[ai][bj][m][1];
                u32x4 w; w.x = cvt_pk_bf16(v0[0], v0[1]); w.y = cvt_pk_bf16(v0[2], v0[3]); w.z = cvt_pk_bf16(v1[0], v1[1]); w.w = cvt_pk_bf16(v1[2], v1[3]);
                *(u32x4*)(rowp + bj * HALF) = w; } }
}
struct EpiProj {
    static constexpr bool PERM = true, AFTER_DRAIN = false;
    bf16_t* O; int ldc;
    __device__ __forceinline__ void operator()(const f32x4 (&acc)[2][2][4][2], const Unit& u, int wr, int wc, int fr, int fq) const {
        store_tile_bf16(acc, O + (size_t)u.pm * BM * ldc + (size_t)u.pn * BM, ldc, wr, wc, fr, fq); }
};
struct SchedKV {
    const char* mn; const char* wkv; int G, c;
    __device__ __forceinline__ bool next(int i, Unit& u) const { const int L = i * G + c; if (L >= 16) return false; u.pm = L; u.pn = 0; return true; }
    __device__ __forceinline__ const char* a_base(const Unit& u) const { return u.pm < 8 ? mn : wkv + (size_t)(2048 + (u.pm - 8) * 256) * 2048 * 2; }
    __device__ __forceinline__ const char* b_base(const Unit& u) const { return u.pm < 8 ? wkv + (size_t)(u.pm * 256) * 2048 * 2 : mn; }
};
struct EpiKV {
    static constexpr bool PERM = true, AFTER_DRAIN = false;
    bf16_t* Kb; bf16_t* Vt;
    __device__ __forceinline__ void operator()(const f32x4 (&acc)[2][2][4][2], const Unit& u, int wr, int wc, int fr, int fq) const {
        if (u.pm < 8) store_tile_bf16(acc, Kb + (size_t)u.pm * BM, 2048, wr, wc, fr, fq);
        else store_tile_bf16(acc, Vt + (size_t)(u.pm - 8) * BM * 256, 256, wr, wc, fr, fq); }
};
struct EpiRes1 {
    static constexpr bool PERM = true, AFTER_DRAIN = false;
    const float* x; float* h1; bf16_t* h1b; float* rowss;
    __device__ __forceinline__ void operator()(const f32x4 (&acc)[2][2][4][2], const Unit& u, int wr, int wc, int fr, int fq) const {
#pragma unroll
        for (int ai = 0; ai < 2; ++ai)
#pragma unroll
            for (int m = 0; m < 4; ++m) { const int row = u.pm * BM + ai * HALF + wr * 64 + m * 16 + fr; float ss = 0.f;
#pragma unroll
                for (int bj = 0; bj < 2; ++bj) { const size_t off = (size_t)row * DM + u.pn * BM + bj * HALF + wc * 32 + 8 * fq;
                    const f32x4 v0 = *(const f32x4*)(x + off) + acc[ai][bj][m][0], v1 = *(const f32x4*)(x + off + 4) + acc[ai][bj][m][1];
                    *(f32x4*)(h1 + off) = v0; *(f32x4*)(h1 + off + 4) = v1;
                    ss += (v0[0] * v0[0] + v0[1] * v0[1]) + (v0[2] * v0[2] + v0[3] * v0[3]) + (v1[0] * v1[0] + v1[1] * v1[1]) + (v1[2] * v1[2] + v1[3] * v1[3]);
                    u32x4 w; w.x = cvt_pk_bf16(v0[0], v0[1]); w.y = cvt_pk_bf16(v0[2], v0[3]); w.z = cvt_pk_bf16(v1[0], v1[1]); w.w = cvt_pk_bf16(v1[2], v1[3]);
                    *(u32x4*)(h1b + off) = w; }
                ss += __shfl_xor(ss, 16); ss += __shfl_xor(ss, 32);
                if (fq == 0) atomicAdd(rowss + row, ss); }
    }
};
struct EpiQ {
    static constexpr bool PERM = true, AFTER_DRAIN = false;
    bf16_t* Q; const float* rowss; float c;
    __device__ __forceinline__ void operator()(const f32x4 (&acc)[2][2][4][2], const Unit& u, int wr, int wc, int fr, int fq) const {
#pragma unroll
        for (int ai = 0; ai < 2; ++ai)
#pragma unroll
            for (int m = 0; m < 4; ++m) { const int row = u.pm * BM + ai * HALF + wr * 64 + m * 16 + fr;
                const float rs = c / sqrtf(rowss[row] * (1.0f / DM) + RMS_EPS);
#pragma unroll
                for (int bj = 0; bj < 2; ++bj) { const size_t off = (size_t)row * DM + u.pn * BM + bj * HALF + wc * 32 + 8 * fq;
                    const f32x4 v0 = acc[ai][bj][m][0] * rs, v1 = acc[ai][bj][m][1] * rs;
                    u32x4 w; w.x = cvt_pk_bf16(v0[0], v0[1]); w.y = cvt_pk_bf16(v0[2], v0[3]); w.z = cvt_pk_bf16(v1[0], v1[1]); w.w = cvt_pk_bf16(v1[2], v1[3]);
                    *(u32x4*)(Q + off) = w; } }
    }
};
struct SchedS {
    const char* q; const char* kb; int G, c;
    __device__ __forceinline__ bool next(int i, Unit& u) const { const int L = i * G + c; if (L >= 128) return false; u.pm = L >> 2; u.pn = L & 3; return true; }
    __device__ __forceinline__ const char* a_base(const Unit& u) const { return q + ((size_t)u.pm * BM * DM + (size_t)u.pn * XHD) * 2; }
    __device__ __forceinline__ const char* b_base(const Unit& u) const { return kb + (size_t)u.pn * XHD * 2; }
};
struct EpiSoftmax {
    static constexpr bool PERM = true, AFTER_DRAIN = true;
    bf16_t* P; float* lpart;
    __device__ __forceinline__ void fused(const f32x4 (&acc)[2][2][4][2], const Unit& u, int wr, int wc, int fr, int fq, PG8_LAS unsigned char* lds, int wid, int lane) const {
        PG8_LAS float* Pm = (PG8_LAS float*)lds;
#pragma unroll
        for (int ai = 0; ai < 2; ++ai)
#pragma unroll
            for (int m = 0; m < 4; ++m) { float mx = -3.0e38f;
#pragma unroll
                for (int bj = 0; bj < 2; ++bj)
#pragma unroll
                    for (int n = 0; n < 2; ++n) { const f32x4 v = acc[ai][bj][m][n]; mx = fmaxf(mx, fmaxf(fmaxf(v[0], v[1]), fmaxf(v[2], v[3]))); }
                mx = fmaxf(mx, __shfl_xor(mx, 16)); mx = fmaxf(mx, __shfl_xor(mx, 32));
                if (fq == 0) Pm[(ai * HALF + wr * 64 + m * 16 + fr) * 4 + wc] = mx; }
        asm volatile("s_waitcnt lgkmcnt(0)" ::: "memory"); __builtin_amdgcn_s_barrier(); asm volatile("" ::: "memory");
#pragma unroll
        for (int ai = 0; ai < 2; ++ai)
#pragma unroll
            for (int m = 0; m < 4; ++m) { const int r = ai * HALF + wr * 64 + m * 16 + fr; const int row = u.pm * BM + r;
                const f32x4 pm4 = *(const PG8_LAS f32x4*)(Pm + r * 4); const float mx = fmaxf(fmaxf(pm4[0], pm4[1]), fmaxf(pm4[2], pm4[3]));
                float l = 0.f;
#pragma unroll
                for (int bj = 0; bj < 2; ++bj) { f32x4 v0 = acc[ai][bj][m][0], v1 = acc[ai][bj][m][1];
#pragma unroll
                    for (int e = 0; e < 4; ++e) { v0[e] = __builtin_amdgcn_exp2f(v0[e] - mx); v1[e] = __builtin_amdgcn_exp2f(v1[e] - mx); }
                    l += (v0[0] + v0[1]) + (v0[2] + v0[3]) + (v1[0] + v1[1]) + (v1[2] + v1[3]);
                    u32x4 w; w.x = cvt_pk_bf16(v0[0], v0[1]); w.y = cvt_pk_bf16(v0[2], v0[3]); w.z = cvt_pk_bf16(v1[0], v1[1]); w.w = cvt_pk_bf16(v1[2], v1[3]);
                    *(u32x4*)(P + (size_t)row * 1024 + u.pn * 256 + bj * HALF + wc * 32 + 8 * fq) = w; }
                l += __shfl_xor(l, 16); l += __shfl_xor(l, 32);
                if (fq == 0) lpart[(size_t)row * 16 + u.pn * 4 + wc] = l; }
    }
};
struct SchedO {
    const char* p; const char* vt; int G, c;
    __device__ __forceinline__ bool next(int i, Unit& u) const { const int L = i * G + c; if (L >= 256) return false; u.pm = L >> 3; u.pn = L & 7; return true; }
    __device__ __forceinline__ const char* a_base(const Unit& u) const { return p + ((size_t)u.pm * BM * 1024 + (size_t)(u.pn >> 1) * 256) * 2; }
    __device__ __forceinline__ const char* b_base(const Unit& u) const { return vt + (size_t)u.pn * BM * 256 * 2; }
};
struct EpiO {
    static constexpr bool PERM = true, AFTER_DRAIN = false;
    bf16_t* O; const float* lpart;
    __device__ __forceinline__ void operator()(const f32x4 (&acc)[2][2][4][2], const Unit& u, int wr, int wc, int fr, int fq) const {
#pragma unroll
        for (int ai = 0; ai < 2; ++ai)
#pragma unroll
            for (int m = 0; m < 4; ++m) { const int row = u.pm * BM + ai * HALF + wr * 64 + m * 16 + fr;
                const f32x4 lp = *(const f32x4*)(lpart + (size_t)row * 16 + (u.pn >> 1) * 4); const float inv = 1.0f / ((lp[0] + lp[1]) + (lp[2] + lp[3]));
#pragma unroll
                for (int bj = 0; bj < 2; ++bj) { const size_t off = (size_t)row * DM + u.pn * BM + bj * HALF + wc * 32 + 8 * fq;
                    const f32x4 v0 = acc[ai][bj][m][0] * inv, v1 = acc[ai][bj][m][1] * inv;
                    u32x4 w; w.x = cvt_pk_bf16(v0[0], v0[1]); w.y = cvt_pk_bf16(v0[2], v0[3]); w.z = cvt_pk_bf16(v1[0], v1[1]); w.w = cvt_pk_bf16(v1[2], v1[3]);
                    *(u32x4*)(O + off) = w; } }
    }
};
struct EpiRes2 {
    static constexpr bool PERM = true, AFTER_DRAIN = false;
    float* out;
    __device__ __forceinline__ void operator()(const f32x4 (&acc)[2][2][4][2], const Unit& u, int wr, int wc, int fr, int fq) const {
#pragma unroll
        for (int ai = 0; ai < 2; ++ai)
#pragma unroll
            for (int m = 0; m < 4; ++m) { const int row = u.pm * BM + ai * HALF + wr * 64 + m * 16 + fr;
#pragma unroll
                for (int bj = 0; bj < 2; ++bj) { const size_t off = (size_t)row * DM + u.pn * BM + bj * HALF + wc * 32 + 8 * fq;
                    const f32x4 v0 = *(const f32x4*)(out + off) + acc[ai][bj][m][0], v1 = *(const f32x4*)(out + off + 4) + acc[ai][bj][m][1];
                    *(f32x4*)(out + off) = v0; *(f32x4*)(out + off + 4) = v1; } }
    }
};
}

__device__ __forceinline__ void p0_transpose_item(const float* W, int K, int N, bf16* WT, int row_off, const float* g, LAS float* scr, int item, int lane) {
    const int nblk = N / 32, kb = item / nblk, nb = item % nblk, k0 = 64 * kb, n0 = 32 * nb;
#pragma unroll 8
    for (int i = 0; i < 32; ++i) { const int kk = 2 * i + (lane >> 5); float v = W[(size_t)(k0 + kk) * N + n0 + (lane & 31)]; if (g) v *= g[k0 + kk]; scr[kk * 33 + (lane & 31)] = v; }
    LDS_WAIT(); asm volatile("" ::: "memory");
    const int c = lane & 7;
#pragma unroll
    for (int j = 0; j < 4; ++j) { const int n = (lane >> 3) + 8 * j; const LAS float* s = scr + (8 * c) * 33 + n;
        v4u o; o.x = pk2(s[0 * 33], s[1 * 33]); o.y = pk2(s[2 * 33], s[3 * 33]); o.z = pk2(s[4 * 33], s[5 * 33]); o.w = pk2(s[6 * 33], s[7 * 33]);
        *(v4u*)(WT + (size_t)(row_off + n0 + n) * K + k0 + 8 * c) = o; }
    LDS_WAIT(); asm volatile("" ::: "memory");
}
__device__ __forceinline__ void rms_row_to_bf16(const float* xrow, const float* g, bf16* orow, int lane) {
    const f32x4* xr = (const f32x4*)xrow + lane; const f32x4* gr = (const f32x4*)g + lane;
    f32x4 v[8]; float s = 0.f;
#pragma unroll
    for (int j = 0; j < 8; ++j) { v[j] = xr[64 * j]; s += (v[j][0] * v[j][0] + v[j][1] * v[j][1]) + (v[j][2] * v[j][2] + v[j][3] * v[j][3]); }
    const float rstd = 1.0f / sqrtf(wave_sum(s) * (1.0f / DM) + RMS_EPS);
    v2u* o8 = (v2u*)orow + lane;
#pragma unroll
    for (int j = 0; j < 8; ++j) { const f32x4 gg = gr[64 * j]; v2u o; o.x = pk2(v[j][0] * rstd * gg[0], v[j][1] * rstd * gg[1]); o.y = pk2(v[j][2] * rstd * gg[2], v[j][3] * rstd * gg[3]); o8[64 * j] = o; }
}
__device__ __forceinline__ void p0a_prologue(Frame& F) {
    LAS float* scr = (LAS float*)(F.lds + F.wave * 16384);
    const int gw = F.vcu * NWAVES + F.wave, NGW = F.G * NWAVES;
    bf16* Wkv_t = (bf16*)(F.ws + WS_WKV);
    constexpr int I_KV = (DM / 64) * (2 * DM / 32);
    for (int m = gw; m < NMEM; m += NGW) rms_row_to_bf16(F.mem + (size_t)m * DM, F.g_mem, (bf16*)(F.ws + WS_MN) + (size_t)m * DM, F.lane);
    for (int it = gw; it < I_KV; it += NGW) p0_transpose_item(F.w_kv, DM, 2 * DM, Wkv_t, 0, nullptr, scr, it, F.lane);
    float* rowss = (float*)(F.ws + WS_ROWSS);
    for (int i = F.vcu * NWAVES * 64 + F.tid; i < SEQ; i += F.G * NWAVES * 64) rowss[i] = 0.f;
}
__device__ __forceinline__ void p0b_prologue(Frame& F, int gw, int NGW) {
    LAS float* scr = (LAS float*)(F.lds + F.wave * 16384);
    bf16* Win_t = (bf16*)(F.ws + WS_WIN); bf16* Wout_t = (bf16*)(F.ws + WS_WOUT); bf16* Wq_t = (bf16*)(F.ws + WS_WQ); bf16* Wo_t = (bf16*)(F.ws + WS_WO); bf16* Wg_t = (bf16*)(F.ws + WS_WG);
    constexpr int I_IN = (DM / 64) * (INC / 32), I_OUT = (MIXW / 64) * (DM / 32), I_Q = (DM / 64) * (DM / 32), I_O = I_Q, I_G = 2 * NHB * 8;
    constexpr int NITEMS = I_IN + I_OUT + I_Q + I_O + I_G;
    for (int m = gw; m < SEQ; m += NGW) rms_row_to_bf16(F.x + (size_t)m * DM, F.g_mix, (bf16*)(F.ws + WS_XN) + (size_t)m * DM, F.lane);
    for (int it = gw; it < NITEMS; it += NGW) {
        int r = it;
        if (r < I_IN) { p0_transpose_item(F.w_in, DM, INC, Win_t, 0, nullptr, scr, r, F.lane); continue; } r -= I_IN;
        if (r < I_OUT) { p0_transpose_item(F.w_out, MIXW, DM, Wout_t, 0, nullptr, scr, r, F.lane); continue; } r -= I_OUT;
        if (r < I_Q) { p0_transpose_item(F.w_q, DM, DM, Wq_t, 0, F.g_x, scr, r, F.lane); continue; } r -= I_Q;
        if (r < I_O) { p0_transpose_item(F.w_o, DM, DM, Wo_t, 0, nullptr, scr, r, F.lane); continue; } r -= I_O;
        { const int gate = r / (NHB * 8), hh = (r / 8) % NHB, sub = r % 8;
          p0_transpose_item((gate ? F.w_i : F.w_r) + (size_t)hh * HD * HD, HD, HD, Wg_t + (size_t)hh * 256 * HD, gate * HD, nullptr, scr, sub, F.lane); }
    }
}

__device__ __forceinline__ void conva_unit(Frame& F, int cidx) {
    const bf16* proj = (const bf16*)(F.ws + WS_PROJ); bf16* ycat = (bf16*)(F.ws + WS_YCAT);
    const int chb = (F.tid & 255) * 8, tstart = cidx * 32 + (F.tid >> 8) * 16;
    f32x4 w0[2], w1[2], w2[2], bb[2], cm2[2], cm1[2];
#pragma unroll
    for (int e = 0; e < 2; ++e) { w0[e] = *(const f32x4*)(F.caw + chb + 4 * e); w1[e] = *(const f32x4*)(F.caw + DM + chb + 4 * e); w2[e] = *(const f32x4*)(F.caw + 2 * DM + chb + 4 * e); bb[e] = *(const f32x4*)(F.cab + chb + 4 * e);
        cm2[e] = (f32x4){0.f, 0.f, 0.f, 0.f}; cm1[e] = cm2[e]; }
#pragma unroll
    for (int k = 0; k < 2; ++k) { const int tt = tstart - 2 + k;
        if (tt >= 0) { const v4u v = *(const v4u*)(proj + (size_t)tt * INC + chb), c = *(const v4u*)(proj + (size_t)tt * INC + 2 * DM + chb);
            f32x4 c0 = (f32x4){bflo(c.x) * bflo(v.x), bfhi(c.x) * bfhi(v.x), bflo(c.y) * bflo(v.y), bfhi(c.y) * bfhi(v.y)};
            f32x4 c1 = (f32x4){bflo(c.z) * bflo(v.z), bfhi(c.z) * bfhi(v.z), bflo(c.w) * bflo(v.w), bfhi(c.w) * bfhi(v.w)};
            if (k == 0) { cm2[0] = c0; cm2[1] = c1; } else { cm1[0] = c0; cm1[1] = c1; } } }
#pragma unroll 4
    for (int r = 0; r < 16; ++r) { const size_t ro = (size_t)(tstart + r) * INC + chb;
        const v4u v = *(const v4u*)(proj + ro), b = *(const v4u*)(proj + ro + DM), c = *(const v4u*)(proj + ro + 2 * DM), g = *(const v4u*)(proj + ro + 3 * DM);
        const f32x4 c0 = (f32x4){bflo(c.x) * bflo(v.x), bfhi(c.x) * bfhi(v.x), bflo(c.y) * bflo(v.y), bfhi(c.y) * bfhi(v.y)};
        const f32x4 c1 = (f32x4){bflo(c.z) * bflo(v.z), bfhi(c.z) * bfhi(v.z), bflo(c.w) * bflo(v.w), bfhi(c.w) * bfhi(v.w)};
        const f32x4 cv0 = bb[0] + w0[0] * cm2[0] + w1[0] * cm1[0] + w2[0] * c0, cv1 = bb[1] + w0[1] * cm2[1] + w1[1] * cm1[1] + w2[1] * c1;
        const f32x4 g0 = (f32x4){bflo(g.x), bfhi(g.x), bflo(g.y), bfhi(g.y)}, g1 = (f32x4){bflo(g.z), bfhi(g.z), bflo(g.w), bfhi(g.w)};
        const f32x4 b0 = (f32x4){bflo(b.x), bfhi(b.x), bflo(b.y), bfhi(b.y)}, b1 = (f32x4){bflo(b.z), bfhi(b.z), bflo(b.w), bfhi(b.w)};
        f32x4 y0, y1;
#pragma unroll
        for (int e = 0; e < 4; ++e) { y0[e] = b0[e] * cv0[e] * g0[e] * sigmoidf_(g0[e]); y1[e] = b1[e] * cv1[e] * g1[e] * sigmoidf_(g1[e]); }
        v4u o; o.x = pk2(y0[0], y0[1]); o.y = pk2(y0[2], y0[3]); o.z = pk2(y1[0], y1[1]); o.w = pk2(y1[2], y1[3]);
        *(v4u*)(ycat + (size_t)(tstart + r) * MIXW + chb) = o;
        cm2[0] = cm1[0]; cm2[1] = cm1[1]; cm1[0] = c0; cm1[1] = c1; }
}

constexpr int SC_RAW = 0, SC_RAWS = 272, SC_XB = 18432, SC_XBS = 272, SC_XF = 35840, SC_XFS = 528, SC_GT = 69632, SC_GTS = 272, SC_GTB = 17408;
constexpr int NGRP = SEQ / 512;
__device__ __forceinline__ float fast_sigmoid(float x) { return __builtin_amdgcn_rcpf(1.0f + __builtin_amdgcn_exp2f(-1.4426950408889634f * x)); }
template <int PASS>
__device__ __forceinline__ void scan_super(Frame& F, int g, int h) {
    LAS unsigned char* L = F.lds;
    const bf16* proj = (const bf16*)(F.ws + WS_PROJ);
    const int tid = F.tid, lane = F.lane, w = F.wave, fr = lane & 15, fq = lane >> 4;
    const int chl = w * 16 + fr, ch = h * HD + chl;
    const int cg8 = tid & 15, r0 = tid >> 4, chb = h * HD + cg8 * 8;
    f32x4 wk[4][2], bb[2];
#pragma unroll
    for (int k = 0; k < 4; ++k) { wk[k][0] = *(const f32x4*)(F.cbw + k * DM + chb); wk[k][1] = *(const f32x4*)(F.cbw + k * DM + chb + 4); }
    bb[0] = *(const f32x4*)(F.cbb + chb); bb[1] = *(const f32x4*)(F.cbb + chb + 4);
    const bf16* wg = (const bf16*)(F.ws + WS_WG) + ((size_t)(h * 256 + chl)) * HD + fq * 8;
    bf16x8 br[4], bi[4];
#pragma unroll
    for (int ks = 0; ks < 4; ++ks) { br[ks] = *(const bf16x8*)(wg + ks * 32); bi[ks] = *(const bf16x8*)(wg + HD * HD + ks * 32); }
    const float brg = F.b_r[ch], big = F.b_i[ch], c8l = -8.0f * 1.4426950408889634f * log1pf(expf(-F.lam[ch]));
    float hcar = 0.f, Pacc = 1.f;
    if (PASS == 1) { const f32x2* ag = (const f32x2*)(F.ws + WS_AGG) + ch;
        for (int gg = 0; gg < g; ++gg) { const f32x2 v = ag[(size_t)gg * DM]; hcar = v[0] * hcar + v[1]; } }
    v4u pr[3], pg[2];
#define SC_LOADTILE(T0) do { _Pragma("unroll") for (int i_ = 0; i_ < 3; ++i_) { const int p_ = tid + i_ * 512, tt_ = (T0) - 3 + (p_ >> 4); pr[i_] = (v4u){0u, 0u, 0u, 0u}; \
        if (p_ < 1072 && tt_ >= 0) pr[i_] = *(const v4u*)(proj + (size_t)tt_ * INC + 4 * DM + h * HD + (p_ & 15) * 8); } \
        if (PASS == 1) { _Pragma("unroll") for (int i_ = 0; i_ < 2; ++i_) { const int p_ = tid + i_ * 512; pg[i_] = *(const v4u*)(proj + (size_t)((T0) + (p_ >> 4)) * INC + 5 * DM + h * HD + (p_ & 15) * 8); } } } while (0)
    SC_LOADTILE(g * 512);
    for (int cc = 0; cc < 8; ++cc) {
        const int t0 = g * 512 + cc * 64; const int gtb = SC_GT + (cc & 1) * SC_GTB;
#pragma unroll
        for (int i = 0; i < 3; ++i) { const int p = tid + i * 512; if (p < 1072) *(LAS v4u*)(L + SC_RAW + (p >> 4) * SC_RAWS + (p & 15) * 16) = pr[i]; }
        if (PASS == 1) {
#pragma unroll
            for (int i = 0; i < 2; ++i) { const int p = tid + i * 512; *(LAS v4u*)(L + gtb + (p >> 4) * SC_GTS + (p & 15) * 16) = pg[i]; } }
        __syncthreads();
        if (cc < 7) SC_LOADTILE(t0 + 64);
#pragma unroll
        for (int it = 0; it < 2; ++it) { const int r = r0 + it * 32;
            f32x4 a0 = bb[0], a1 = bb[1];
#pragma unroll
            for (int k = 0; k < 4; ++k) { const v4u v = *(const LAS v4u*)(L + SC_RAW + (r + k) * SC_RAWS + cg8 * 16);
                a0 += wk[k][0] * (f32x4){bflo(v.x), bfhi(v.x), bflo(v.y), bfhi(v.y)}; a1 += wk[k][1] * (f32x4){bflo(v.z), bfhi(v.z), bflo(v.w), bfhi(v.w)}; }
            v4u o; o.x = pk2(a0[0], a0[1]); o.y = pk2(a0[2], a0[3]); o.z = pk2(a1[0], a1[1]); o.w = pk2(a1[2], a1[3]);
            *(LAS v4u*)(L + SC_XB + r * SC_XBS + cg8 * 16) = o;
            *(LAS f32x4*)(L + SC_XF + r * SC_XFS + cg8 * 32) = a0; *(LAS f32x4*)(L + SC_XF + r * SC_XFS + cg8 * 32 + 16) = a1; }
        __syncthreads();
        f32x4 ar[4], ai[4];
#pragma unroll
        for (int rb = 0; rb < 4; ++rb) { ar[rb] = (f32x4){0.f, 0.f, 0.f, 0.f}; ai[rb] = ar[rb];
#pragma unroll
            for (int ks = 0; ks < 4; ++ks) { const bf16x8 a = *(const LAS bf16x8*)(L + SC_XB + (rb * 16 + fr) * SC_XBS + (ks * 32 + fq * 8) * 2);
                ar[rb] = __builtin_amdgcn_mfma_f32_16x16x32_bf16(a, br[ks], ar[rb], 0, 0, 0); ai[rb] = __builtin_amdgcn_mfma_f32_16x16x32_bf16(a, bi[ks], ai[rb], 0, 0, 0); } }
        f32x4 Pv[4], Hv[4];
#pragma unroll
        for (int rb = 0; rb < 4; ++rb) { float Pc = 1.f, Hc = 0.f;
#pragma unroll
            for (int idx = 0; idx < 4; ++idx) { const int tl = rb * 16 + fq * 4 + idx;
                const float xc = *(const LAS float*)(L + SC_XF + tl * SC_XFS + chl * 4);
                const float r = fast_sigmoid(ar[rb][idx] + brg), ig = fast_sigmoid(ai[rb][idx] + big);
                const float a = __builtin_amdgcn_exp2f(c8l * r); float mult = __builtin_amdgcn_sqrtf(fmaxf(1.0f - a * a, 0.f)); if (t0 + tl == 0) mult = 1.0f;
                const float uu = mult * ig * xc;
                Hc = a * Hc + uu; Pc *= a; Pv[rb][idx] = Pc; Hv[rb][idx] = Hc; } }
#pragma unroll
        for (int rb = 0; rb < 4; ++rb) {
            float Pt = Pv[rb][3], Ht = Hv[rb][3];
            float Pp = __shfl_up(Pt, 16), Hp = __shfl_up(Ht, 16); if (fq >= 1) { Ht = Pt * Hp + Ht; Pt = Pt * Pp; }
            Pp = __shfl_up(Pt, 32); Hp = __shfl_up(Ht, 32); if (fq >= 2) { Ht = Pt * Hp + Ht; Pt = Pt * Pp; }
            float Pe = __shfl_up(Pt, 16), He = __shfl_up(Ht, 16); if (fq == 0) { Pe = 1.f; He = 0.f; }
            const float Ptot = __shfl(Pt, fr + 48), Htot = __shfl(Ht, fr + 48);
            if (PASS == 1) { const float hent = Pe * hcar + He;
#pragma unroll
                for (int idx = 0; idx < 4; ++idx) { const int tl = rb * 16 + fq * 4 + idx; const float hv = Pv[rb][idx] * hent + Hv[rb][idx];
                    LAS unsigned short* gp = (LAS unsigned short*)(L + gtb + tl * SC_GTS + chl * 2);
                    const float gg = __builtin_bit_cast(float, (unsigned)(*gp) << 16); const float y = hv * gg * fast_sigmoid(gg);
                    *gp = (unsigned short)(pk2(y, 0.f) & 0xffffu); } }
            hcar = Ptot * hcar + Htot; Pacc *= Ptot;
        }
        if (PASS == 1) { __syncthreads();
            bf16* ycat = (bf16*)(F.ws + WS_YCAT);
#pragma unroll
            for (int it = 0; it < 2; ++it) { const int r = r0 + it * 32;
                *(v4u*)(ycat + (size_t)(t0 + r) * MIXW + DM + h * HD + cg8 * 8) = *(const LAS v4u*)(L + gtb + r * SC_GTS + cg8 * 16); } }
    }
#undef SC_LOADTILE
    if (PASS == 0) { if (fq == 0) *((f32x2*)(F.ws + WS_AGG) + (size_t)g * DM + ch) = (f32x2){Pacc, hcar}; }
    __syncthreads();
}

__device__ __forceinline__ void final_norm_row(float* row, const float* g, int lane) {
    f32x4* xr = (f32x4*)row + lane; const f32x4* gr = (const f32x4*)g + lane;
    f32x4 v[8]; float s = 0.f;
#pragma unroll
    for (int j = 0; j < 8; ++j) { v[j] = xr[64 * j]; s += (v[j][0] * v[j][0] + v[j][1] * v[j][1]) + (v[j][2] * v[j][2] + v[j][3] * v[j][3]); }
    const float rstd = 1.0f / sqrtf(wave_sum(s) * (1.0f / DM) + RMS_EPS);
#pragma unroll
    for (int j = 0; j < 8; ++j) xr[64 * j] = v[j] * rstd * gr[64 * j];
}

__global__ void __launch_bounds__(NWAVES * 64, 2) hymba_fwd(Args args) {
    extern __shared__ __attribute__((aligned(16))) unsigned char lds[];
    cg::grid_group grid = cg::this_grid();
    Frame F;
    F.lds = (LAS unsigned char*)lds;
    F.tid = threadIdx.x; F.lane = F.tid & 63; F.wave = __builtin_amdgcn_readfirstlane(F.tid >> 6);
    F.G = gridDim.x; { const int bx = blockIdx.x; F.vcu = (F.G % 8 == 0) ? (bx % 8) * (F.G / 8) + bx / 8 : bx; }
    F.x = args.in[0]; F.mem = args.in[1]; F.g_mix = args.in[2]; F.w_in = args.in[3]; F.caw = args.in[4]; F.cab = args.in[5]; F.cbw = args.in[6]; F.cbb = args.in[7];
    F.w_r = args.in[8]; F.b_r = args.in[9]; F.w_i = args.in[10]; F.b_i = args.in[11]; F.lam = args.in[12]; F.w_out = args.in[13]; F.g_x = args.in[14]; F.g_mem = args.in[15];
    F.w_q = args.in[16]; F.w_kv = args.in[17]; F.w_o = args.in[18]; F.g_f = args.in[19]; F.out = args.out; F.ws = args.ws;
    unsigned char* ws = args.ws;
    const int lo = args.ph_lo, hi = args.ph_hi;
    volatile LAS unsigned* MISC = (volatile LAS unsigned*)(F.lds + RING_BYTES + 64);
    if (F.tid < 2) MISC[F.tid] = 0u;
    __syncthreads();
    XcdBarrier bar = xcd_barrier_post((unsigned*)(ws + WS_BAR) + args.li * XCD_BAR_WORDS, MISC);
    if (lo < 0) grid.sync();
#define IN(k) (lo <= (k) && (k) < hi)
#define SEAM(k) do { if (IN(k) && IN((k) + 1)) xcd_barrier(bar); } while (0)

    if (IN(0)) {
        p0a_prologue(F);
        xcd_barrier(bar);
        const bool kvwg = (F.G == 256) && (blockIdx.x < 16);
        if (kvwg) {
            pg8::Gemm g{DM, DM, DM}; pg8::SchedKV S{(const char*)(ws + WS_MN), (const char*)(ws + WS_WKV), F.G, (int)blockIdx.x};
            pg8::EpiKV E{(pg8::bf16_t*)(ws + WS_KB), (pg8::bf16_t*)(ws + WS_VT)};
            pg8::gemm_phase<pg8::EpiKV, pg8::SchedKV, true>(F.lds, g, S, E);
        } else if (F.G == 256) {
            const int rank = (F.vcu >> 5) * 30 + (F.vcu & 31) - 2;
            p0b_prologue(F, rank * NWAVES + F.wave, 240 * NWAVES);
        } else {
            p0b_prologue(F, F.vcu * NWAVES + F.wave, F.G * NWAVES);
        }
    }
    SEAM(0);
    if (IN(1)) {
        { pg8::Gemm g{DM, DM, DM}; pg8::SchedStd S; S.init(ws + WS_XN, DM, ws + WS_WIN, DM, SEQ, INC, F.G, (int)blockIdx.x);
          pg8::EpiProj E{(pg8::bf16_t*)(ws + WS_PROJ), INC};
          pg8::gemm_phase<pg8::EpiProj, pg8::SchedStd, true>(F.lds, g, S, E); }
        if (F.G != 256) { pg8::Gemm g{DM, DM, DM}; pg8::SchedKV S{(const char*)(ws + WS_MN), (const char*)(ws + WS_WKV), F.G, (int)blockIdx.x};
          pg8::EpiKV E{(pg8::bf16_t*)(ws + WS_KB), (pg8::bf16_t*)(ws + WS_VT)};
          pg8::gemm_phase<pg8::EpiKV, pg8::SchedKV, true>(F.lds, g, S, E); }
    }
    SEAM(1);
    if (IN(2)) {
        for (int u = F.vcu; u < SEQ / 32; u += F.G) conva_unit(F, u);
        for (int u = F.vcu; u < NGRP * NHB; u += F.G) scan_super<0>(F, u >> 4, u & 15);
    }
    SEAM(2);
    if (IN(3)) {
        for (int u = F.vcu; u < NGRP * NHB; u += F.G) scan_super<1>(F, u >> 4, u & 15);
    }
    SEAM(3);
    if (IN(4)) {
        pg8::Gemm g{MIXW, MIXW, MIXW}; pg8::SchedStd S; S.init(ws + WS_YCAT, MIXW, ws + WS_WOUT, MIXW, SEQ, DM, F.G, (int)blockIdx.x);
        pg8::EpiRes1 E{F.x, F.out, (pg8::bf16_t*)(ws + WS_H1B), (float*)(ws + WS_ROWSS)};
        pg8::gemm_phase<pg8::EpiRes1, pg8::SchedStd, true>(F.lds, g, S, E);
    }
    SEAM(4);
    if (IN(5)) {
        pg8::Gemm g{DM, DM, DM}; pg8::SchedStd S; S.init(ws + WS_H1B, DM, ws + WS_WQ, DM, SEQ, DM, F.G, (int)blockIdx.x);
        pg8::EpiQ E{(pg8::bf16_t*)(ws + WS_Q), (const float*)(ws + WS_ROWSS), 0.04419417382415922f * 1.4426950408889634f};
        pg8::gemm_phase<pg8::EpiQ, pg8::SchedStd, true>(F.lds, g, S, E);
    }
    SEAM(5);
    if (IN(6)) {
        pg8::Gemm g{DM, DM, XHD}; pg8::SchedS S{(const char*)(ws + WS_Q), (const char*)(ws + WS_KB), F.G, (int)blockIdx.x};
        pg8::EpiSoftmax E{(pg8::bf16_t*)(ws + WS_P), (float*)(ws + WS_LP)};
        pg8::gemm_phase<pg8::EpiSoftmax, pg8::SchedS, false>(F.lds, g, S, E);
    }
    SEAM(6);
    if (IN(7)) {
        pg8::Gemm g{1024, 256, 256}; pg8::SchedO S{(const char*)(ws + WS_P), (const char*)(ws + WS_VT), F.G, (int)blockIdx.x};
        pg8::EpiO E{(pg8::bf16_t*)(ws + WS_O), (const float*)(ws + WS_LP)};
        pg8::gemm_phase<pg8::EpiO, pg8::SchedO, true>(F.lds, g, S, E);
    }
    SEAM(7);
    if (IN(8)) {
        pg8::Gemm g{DM, DM, DM}; pg8::SchedStd S; S.init(ws + WS_O, DM, ws + WS_WO, DM, SEQ, DM, F.G, (int)blockIdx.x);
        pg8::EpiRes2 E{F.out};
        pg8::gemm_phase<pg8::EpiRes2, pg8::SchedStd, true>(F.lds, g, S, E);
    }
    SEAM(8);
    if (IN(9)) {
        const int gw = F.vcu * NWAVES + F.wave, NGW = F.G * NWAVES;
        for (int m = gw; m < SEQ; m += NGW) final_norm_row(F.out + (size_t)m * DM, F.g_f, F.lane);
    }
#undef IN
#undef SEAM
}

extern "C" void kernel_launch(void* const* d_in, const int* in_sizes, int n_in, void* d_out, int out_size, void* d_ws, size_t ws_size, hipStream_t stream) {
    static int grid = 0;
    if (grid == 0) {
        if (n_in != 20 || out_size != SEQ * DM || ws_size < WS_END) { fprintf(stderr, "kernel_launch: unexpected shapes (n_in %d out %d ws %zu)\n", n_in, out_size, ws_size); grid = -1; return; }
        int dev = 0, cus = 0, per_cu = 0;
        if (hipGetDevice(&dev) != hipSuccess || hipDeviceGetAttribute(&cus, hipDeviceAttributeMultiprocessorCount, dev) != hipSuccess) { grid = -1; return; }
        if (hipFuncSetAttribute((const void*)hymba_fwd, hipFuncAttributeMaxDynamicSharedMemorySize, LDS_BYTES) != hipSuccess) { fprintf(stderr, "kernel_launch: hipFuncSetAttribute failed\n"); grid = -1; return; }
        if (hipOccupancyMaxActiveBlocksPerMultiprocessor(&per_cu, (const void*)hymba_fwd, NWAVES * 64, LDS_BYTES) != hipSuccess || per_cu < 1) { fprintf(stderr, "kernel_launch: occupancy query says %d\n", per_cu); }
        (void)hipGetLastError();
        grid = cus;
    }
    if (grid < 0) return;
    if (hipMemsetAsync((char*)d_ws, 0, CTL_ZERO_BYTES, stream) != hipSuccess) { fprintf(stderr, "kernel_launch: memset failed\n"); return; }
    Args a{};
    for (int i = 0; i < 20; ++i) a.in[i] = (const float*)d_in[i];
    a.out = (float*)d_out; a.ws = (unsigned char*)d_ws;
    static const int plan[][2] = PHASE_PLAN;
    for (int li = 0; li < (int)(sizeof(plan) / sizeof(plan[0])); ++li) {
        a.ph_lo = plan[li][0]; a.ph_hi = plan[li][1]; a.li = li;
        void* kargs[] = {&a};
        hipError_t e = hipLaunchCooperativeKernel((const void*)hymba_fwd, dim3(grid), dim3(NWAVES * 64), kargs, LDS_BYTES, stream);
        if (e != hipSuccess) { fprintf(stderr, "kernel_launch: cooperative launch %d failed: %s\n", li, hipGetErrorString(e)); break; }
    }
}
```
